# Optimizing an MI355X kernel written in HIP

```python
import jax, jax.numpy as jnp
from jax import lax
import numpy as np

D_MODEL = 2048
BATCH = 16
SEQ = 2048
DEPTH = 1

GRID_W = 64
R_HEADS = 16
R_HEAD_DIM = 64
R_WIDTH = R_HEADS * R_HEAD_DIM
DECAY_LORA = 64
ICLR_LORA = 64
A_Q_HEADS = 16
A_KV_HEADS = 4
A_HEAD_DIM = 64
A_GROUP = A_Q_HEADS // A_KV_HEADS
A_WIDTH = A_Q_HEADS * A_HEAD_DIM
A_KV_WIDTH = A_KV_HEADS * A_HEAD_DIM
AXIS_DIM = A_HEAD_DIM // 2
Q_BLOCK = 128
ROPE_THETA = 10000.0
N_BRANCHES = 2
NORM_EPS = 1e-6
GN_EPS = 64e-5
SHIFT_SIZES = (R_WIDTH, R_WIDTH, R_WIDTH, 2 * DECAY_LORA, 2 * ICLR_LORA)
SHIFT_WIDTH = 3 * R_WIDTH + 2 * DECAY_LORA + 2 * ICLR_LORA
REST_SIZES = (R_WIDTH, A_WIDTH, A_KV_WIDTH, A_KV_WIDTH, A_WIDTH, N_BRANCHES * D_MODEL)
D_IN = SHIFT_WIDTH + 2 * R_WIDTH // 2 * 1 + 2 * A_WIDTH + 2 * A_KV_WIDTH + N_BRANCHES * D_MODEL - R_WIDTH + R_WIDTH // 1 * 0

kernel_name = "hybrid_rwkv7_axial_gqa_gated_block"


def _split(t, sizes):
    out, off = [], 0
    for s in sizes:
        out.append(t[..., off:off + s])
        off += s
    return out


def rms_norm(x, g, eps=NORM_EPS):
    xf = x.astype(jnp.float32)
    y = xf * lax.rsqrt(jnp.mean(xf * xf, axis=-1, keepdims=True) + eps)
    return (y * g.astype(jnp.float32)).astype(x.dtype)


def centred_shift(y, mu):
    prev = jnp.pad(y[:, :-1], ((0, 0), (1, 0), (0, 0)))
    nxt = jnp.pad(y[:, 1:], ((0, 0), (0, 1), (0, 0)))
    return y + mu[0] * (prev - y) + mu[1] * (nxt - y)


def _heads(t):
    return t.reshape(*t.shape[:-1], R_HEADS, R_HEAD_DIM)


def _dir_stack(t):
    s = jnp.stack([t[0], jnp.flip(t[1], axis=1)], axis=0)
    return jnp.moveaxis(s, 2, 0)


def _wkv_step(S, inp):
    w, kk, b, k, v, r = inp
    sa = jnp.einsum('dbhvk,dbhk->dbhv', S, -kk)
    S = S * w[..., None, :] + sa[..., None] * b[..., None, :] + v[..., :, None] * k[..., None, :]
    o = jnp.einsum('dbhvk,dbhk->dbhv', S, r)
    return S, o


def rwkv7_bidir(xr, xk, xv, wdown, adown, w0, w_up, a0, a_up, k_k, k_a, r_k, gn_w, gn_b):
    f32 = jnp.float32
    B, T, C = xr.shape
    wd = jnp.tanh(wdown.astype(f32).reshape(B, T, 2, DECAY_LORA))
    w_raw = w0.astype(f32)[:, None, None, :] + jnp.einsum('btdr,drc->dbtc', wd, w_up.astype(f32))
    decay = jnp.exp(-jnp.exp(-jax.nn.softplus(-w_raw) - 0.5))
    ad = adown.astype(f32).reshape(B, T, 2, ICLR_LORA)
    a = jax.nn.sigmoid(a0.astype(f32)[:, None, None, :] + jnp.einsum('btdr,drc->dbtc', ad, a_up.astype(f32)))
    r = xr.astype(f32)
    k = xk.astype(f32)
    v = xv.astype(f32)
    kkh = _heads(k * k_k.astype(f32))
    kkh = kkh * lax.rsqrt(jnp.maximum(jnp.sum(kkh * kkh, axis=-1, keepdims=True), 1e-24))
    ah = _heads(a)
    k_eff = _heads(k[None] * (1.0 + (a - 1.0) * k_a.astype(f32)))
    rh, vh = _heads(r), _heads(v)
    both = lambda t: jnp.stack([t, t], axis=0)
    seq_in = (_dir_stack(_heads(decay)), _dir_stack(both(kkh)), _dir_stack(kkh[None] * ah),
              _dir_stack(k_eff), _dir_stack(both(vh)), _dir_stack(both(rh)))
    S0 = jnp.zeros((2, B, R_HEADS, R_HEAD_DIM, R_HEAD_DIM), f32)
    _, outs = lax.scan(_wkv_step, S0, seq_in)
    outs = jnp.moveaxis(outs, 0, 2)
    wkv = outs[0] + jnp.flip(outs[1], axis=1)
    mu = jnp.mean(wkv, axis=-1, keepdims=True)
    var = jnp.mean(jnp.square(wkv - mu), axis=-1, keepdims=True)
    gn = (wkv - mu) * lax.rsqrt(var + GN_EPS)
    gn = gn * _heads(gn_w.astype(f32)) + _heads(gn_b.astype(f32))
    coef = jnp.sum(rh[None] * k_eff * _heads(r_k.astype(f32)), axis=-1, keepdims=True).sum(0)
    out = gn + coef * vh
    return out.reshape(B, T, C).astype(xr.dtype)


def axial_rope_tables(T):
    rows = T // GRID_W
    row = jnp.repeat(jnp.arange(rows, dtype=jnp.float32), GRID_W)
    col = jnp.tile(jnp.arange(GRID_W, dtype=jnp.float32), rows)
    freqs = ROPE_THETA ** (-jnp.arange(0, AXIS_DIM, 2, dtype=jnp.float32) / AXIS_DIM)
    ang = jnp.concatenate([row[:, None] * freqs, col[:, None] * freqs], axis=-1)
    return jnp.cos(ang), jnp.sin(ang)


def apply_rope(x, cos, sin):
    xf = x.astype(jnp.float32).reshape(*x.shape[:-1], A_HEAD_DIM // 2, 2)
    x0, x1 = xf[..., 0], xf[..., 1]
    c, s = cos[None, :, None, :], sin[None, :, None, :]
    out = jnp.stack([x0 * c - x1 * s, x0 * s + x1 * c], axis=-1)
    return out.reshape(x.shape).astype(x.dtype)


def axial_gqa(q, k, v, q_norm_g, k_norm_g):
    B, T, _ = q.shape
    q = rms_norm(q.reshape(B, T, A_Q_HEADS, A_HEAD_DIM), q_norm_g)
    k = rms_norm(k.reshape(B, T, A_KV_HEADS, A_HEAD_DIM), k_norm_g)
    v = v.reshape(B, T, A_KV_HEADS, A_HEAD_DIM)
    cos, sin = axial_rope_tables(T)
    q = apply_rope(q, cos, sin)
    k = apply_rope(k, cos, sin)
    scale = A_HEAD_DIM ** -0.5
    nb = T // Q_BLOCK
    qb = q.reshape(B, nb, Q_BLOCK, A_KV_HEADS, A_GROUP, A_HEAD_DIM).transpose(1, 0, 2, 3, 4, 5)

    def one_block(qblk):
        s = jnp.einsum('bqhgd,bkhd->bhgqk', qblk, k).astype(jnp.float32) * scale
        p = jax.nn.softmax(s, axis=-1)
        return jnp.einsum('bhgqk,bkhd->bqhgd', p.astype(v.dtype), v)

    o = lax.map(one_block, qb)
    return o.transpose(1, 0, 2, 3, 4, 5).reshape(B, T, A_WIDTH)


def hybrid_layer(x, norm_g, w_in, shift_mu, w0, w_up, a0, a_up, k_k, k_a, r_k, gn_w, gn_b,
                 q_norm_g, k_norm_g, w_branch_rwkv, w_branch_attn, w_out):
    h = rms_norm(x, norm_g)
    proj = jnp.einsum('btd,de->bte', h, w_in)
    shifted = centred_shift(proj[..., :SHIFT_WIDTH], shift_mu)
    xr, xk, xv, wdown, adown = _split(shifted, SHIFT_SIZES)
    z_r, q, k, v, z_a, gates = _split(proj[..., SHIFT_WIDTH:], REST_SIZES)
    o_r = rwkv7_bidir(xr, xk, xv, wdown, adown, w0, w_up, a0, a_up, k_k, k_a, r_k, gn_w, gn_b)
    o_r = o_r * jax.nn.silu(z_r)
    o_a = axial_gqa(q, k, v, q_norm_g, k_norm_g) * jax.nn.silu(z_a)
    p_r = jnp.einsum('btc,cd->btd', o_r, w_branch_rwkv)
    p_a = jnp.einsum('btc,cd->btd', o_a, w_branch_attn)
    g_r, g_a = _split(gates, (D_MODEL, D_MODEL))
    merged = jax.nn.sigmoid(g_r) * p_r + jax.nn.sigmoid(g_a) * p_a
    return x + jnp.einsum('btd,de->bte', merged, w_out)


def setup_inputs(seed: int = 0) -> dict:
    key = jax.random.key(seed)
    ks = jax.random.split(key, 20)
    f32 = jnp.float32
    nrm = lambda k, s, sc: jax.random.normal(k, s, f32) * sc
    d_in = SHIFT_WIDTH + sum(REST_SIZES)
    return {
        "x": nrm(ks[0], (BATCH, SEQ, D_MODEL), 1.0),
        "norm_g": 1.0 + nrm(ks[1], (DEPTH, D_MODEL), 0.02),
        "w_in": nrm(ks[2], (DEPTH, D_MODEL, d_in), D_MODEL ** -0.5),
        "shift_mu": jax.random.uniform(ks[3], (DEPTH, 2, SHIFT_WIDTH), f32, 0.0, 0.5),
        "w0": jax.random.uniform(ks[4], (DEPTH, 2, R_WIDTH), f32, -5.0, 1.0),
        "w_up": nrm(ks[5], (DEPTH, 2, DECAY_LORA, R_WIDTH), 0.1 * DECAY_LORA ** -0.5),
        "a0": nrm(ks[6], (DEPTH, 2, R_WIDTH), 0.3),
        "a_up": nrm(ks[7], (DEPTH, 2, ICLR_LORA, R_WIDTH), 0.1 * ICLR_LORA ** -0.5),
        "k_k": 0.85 + nrm(ks[8], (DEPTH, R_WIDTH), 0.02),
        "k_a": 1.0 + nrm(ks[9], (DEPTH, R_WIDTH), 0.02),
        "r_k": nrm(ks[10], (DEPTH, R_WIDTH), 0.1),
        "gn_w": 1.0 + nrm(ks[11], (DEPTH, R_WIDTH), 0.02),
        "gn_b": nrm(ks[12], (DEPTH, R_WIDTH), 0.02),
        "q_norm_g": 1.0 + nrm(ks[13], (DEPTH, A_HEAD_DIM), 0.02),
        "k_norm_g": 1.0 + nrm(ks[14], (DEPTH, A_HEAD_DIM), 0.02),
        "w_branch_rwkv": nrm(ks[15], (DEPTH, R_WIDTH, D_MODEL), R_WIDTH ** -0.5),
        "w_branch_attn": nrm(ks[16], (DEPTH, A_WIDTH, D_MODEL), A_WIDTH ** -0.5),
        "w_out": nrm(ks[17], (DEPTH, D_MODEL, D_MODEL), D_MODEL ** -0.5),
        "final_norm_g": 1.0 + nrm(ks[18], (D_MODEL,), 0.02),
    }


def reference(x, norm_g, w_in, shift_mu, w0, w_up, a0, a_up, k_k, k_a, r_k, gn_w, gn_b,
              q_norm_g, k_norm_g, w_branch_rwkv, w_branch_attn, w_out, final_norm_g):
    for l in range(DEPTH):
        x = hybrid_layer(x, norm_g[l], w_in[l], shift_mu[l], w0[l], w_up[l], a0[l], a_up[l],
                         k_k[l], k_a[l], r_k[l], gn_w[l], gn_b[l], q_norm_g[l], k_norm_g[l],
                         w_branch_rwkv[l], w_branch_attn[l], w_out[l])
    return rms_norm(x, final_norm_g)
```

```cpp
#include <hip/hip_runtime.h>
#include <hip/hip_cooperative_groups.h>
#include <cstdio>
#include <cstdint>
namespace cg = cooperative_groups;
#define PROBE_MASK 0
namespace pg8 {
#define PG8_LAS __attribute__((address_space(3)))
typedef unsigned short bf16_t;
typedef short bf16x8 __attribute__((ext_vector_type(8)));
typedef float f32x4 __attribute__((ext_vector_type(4)));
typedef unsigned u32x4 __attribute__((ext_vector_type(4)));
constexpr int BM = 256, BK = 64, HALF = 128, HTB = HALF * BK * 2  , STAGE_BYTES = 8 * HTB, NXCD = 8, WGM = 8;

__host__ __device__ __forceinline__ int lds_byte(int r, int c) { const int st = (r >> 4) * 2 + (c >> 5), rr = r & 15, cc = c & 31, ob = rr * 64 + cc * 2; return st * 1024 + (ob ^ (((ob >> 9) & 1) << 5)); }
__host__ __device__ __forceinline__ void stage_rc(int b, int& R, int& C) { const int st = b / 1024, sb = b % 1024, swz = sb ^ (((sb >> 9) & 1) << 5); R = (st >> 1) * 16 + swz / 64; C = (st & 1) * 32 + (swz % 64) / 2; }
__host__ __device__ __forceinline__ int perm32(int rho) { const int n = rho >> 4, i = rho & 15; return 8 * (i >> 2) + 4 * n + (i & 3); }

struct Unit { int pm, pn; };
struct Gemm { const bf16_t* A; const bf16_t* Bt; int M, N, K; };

struct StaticOrder {
    int nM, nN, nwg, G, c, wgm = 8;
    __host__ __device__ void init(int M, int N, int G_, int c_) { nM = M / BM; nN = N / BM; nwg = nM * nN; G = G_; c = c_; }
    __host__ __device__ bool next(int i, Unit& u) const {
        const long L = (long)i * G + c; if (L >= nwg) return false;
        int wgid = (int)L; { const int q = nwg / NXCD, r = nwg % NXCD, xcd = wgid % NXCD, off = wgid / NXCD; wgid = (xcd < r ? xcd * (q + 1) : r * (q + 1) + (xcd - r) * q) + off; }
        const int nig = wgm * nN, gid = wgid / nig, fm = gid * wgm, gsz = (nM - fm) < wgm ? (nM - fm) : wgm;
        u.pm = fm + ((wgid % nig) % gsz); u.pn = (wgid % nig) / gsz; return true;
    }
    __device__ __forceinline__ void a_ready(const Unit&) const {}
    __device__ __forceinline__ void done(const Unit&) const {}
};
__device__ __forceinline__ unsigned cvt_pk_bf16(float lo, float hi) { unsigned r; asm volatile("v_cvt_pk_bf16_f32 %0, %1, %2" : "=v"(r) : "v"(lo), "v"(hi)); return r; }
template <class Epi, class Sched, bool ALIGN_EPI = false, bool SP2 = false>
__device__ __forceinline__ void gemm_phase(PG8_LAS unsigned char* lds, const Gemm g, const Sched& S, const Epi& E) {
    int tid_l = threadIdx.x; asm volatile("" : "+v"(tid_l)); const int tid = tid_l, wid = __builtin_amdgcn_readfirstlane(tid >> 6), lane = tid & 63, wr = wid >> 2, wc = wid & 3, fr = lane & 15, fq = lane >> 4;
    const int K = g.K, nt = K / BK;
    unsigned voffA[2], voffB[2];
#pragma unroll
    for (int i = 0; i < 2; ++i) { int R, C; stage_rc(tid * 16 + i * 8192, R, C); const int Rb = Epi::PERM ? ((R & ~31) + perm32(R & 31)) : R;
        voffA[i] = (unsigned)(R * K + C) * 2u; voffB[i] = (unsigned)(Rb * K + C) * 2u; }
    const size_t kstep = (size_t)(BK * 2);
    const size_t hstep = (size_t)HALF * K * 2;
    const size_t tstep = 2 * hstep;
    const unsigned ldsw = (unsigned)wid * 1024u;
    const int aoff = lds_byte(wr * 64 + fr, fq * 8), boff = lds_byte(wc * 32 + fr, fq * 8);
#define PG8_SA(b, h) (((b) * 2 + (h)) * HTB)
#define PG8_SB(b, h) ((4 + (b) * 2 + (h)) * HTB)
#define PG8_STAGE(bufoff, gbase, voff) do { _Pragma("unroll") for (int _i = 0; _i < 2; ++_i) \
        __builtin_amdgcn_global_load_lds((const unsigned*)((const char*)(gbase) + (voff)[_i]), (PG8_LAS unsigned*)(lds + (bufoff) + ldsw + _i * 8192), 16, 0, 0); } while (0)
#define PG8_LDA(dst, b, h) do { _Pragma("unroll") for (int m = 0; m < 4; ++m) _Pragma("unroll") for (int k = 0; k < 2; ++k) dst[m][k] = *(const PG8_LAS bf16x8*)(lds + PG8_SA(b, h) + aoff + m * 2048 + k * 1024); } while (0)
#define PG8_LDB(dst, b, h) do { _Pragma("unroll") for (int n = 0; n < 2; ++n) _Pragma("unroll") for (int k = 0; k < 2; ++k) dst[n][k] = *(const PG8_LAS bf16x8*)(lds + PG8_SB(b, h) + boff + n * 2048 + k * 1024); } while (0)
#define PG8_MMA(ai, bj, At, Bt) do { __builtin_amdgcn_s_setprio(1); _Pragma("unroll") for (int m = 0; m < 4; ++m) _Pragma("unroll") for (int n = 0; n < 2; ++n) _Pragma("unroll") for (int k = 0; k < 2; ++k) \
        acc[ai][bj][m][n] = __builtin_amdgcn_mfma_f32_16x16x32_bf16(Bt[n][k], At[m][k], acc[ai][bj][m][n], 0, 0, 0); __builtin_amdgcn_s_setprio(0); } while (0)
#define PG8_WAIT_V(n) asm volatile("s_waitcnt vmcnt(" #n ")" ::: "memory")
#define PG8_WAIT_L(n) asm volatile("s_waitcnt lgkmcnt(" #n ")" ::: "memory")
#define PG8_BAR __builtin_amdgcn_s_barrier()
#define PG8_SCHED __builtin_amdgcn_sched_barrier(0)
    Unit cur, nxt; int ui = 0;
    if (!S.next(0, cur)) return;
    f32x4 acc[2][2][4][2];
#pragma unroll
    for (int a = 0; a < 2; ++a)
#pragma unroll
        for (int b = 0; b < 2; ++b)
#pragma unroll
            for (int m = 0; m < 4; ++m)
#pragma unroll
                for (int n = 0; n < 2; ++n) acc[a][b][m][n] = (f32x4){0.f, 0.f, 0.f, 0.f};
    bf16x8 At[4][2], B0[2][2], B1[2][2];
    const char* cA = (const char*)g.A + (size_t)cur.pm * tstep; const char* cB = (const char*)g.Bt + (size_t)cur.pn * tstep;
    S.a_ready(cur);
    if constexpr (SP2) {
        PG8_STAGE(PG8_SB(0, 0), cB, voffB); PG8_STAGE(PG8_SB(0, 1), cB + hstep, voffB); PG8_STAGE(PG8_SA(0, 0), cA, voffA); PG8_STAGE(PG8_SA(0, 1), cA + hstep, voffA);
        if (wr == 1) PG8_BAR;
        PG8_WAIT_V(2); PG8_BAR;
        PG8_STAGE(PG8_SB(1, 0), cB + kstep, voffB); PG8_STAGE(PG8_SA(1, 0), cA + kstep, voffA); PG8_STAGE(PG8_SB(1, 1), cB + hstep + kstep, voffB);
        PG8_WAIT_V(6); PG8_BAR;
    } else {
        PG8_STAGE(PG8_SB(0, 0), cB, voffB); PG8_STAGE(PG8_SA(0, 0), cA, voffA); PG8_STAGE(PG8_SB(0, 1), cB + hstep, voffB); PG8_STAGE(PG8_SA(0, 1), cA + hstep, voffA);
        if (wr == 1) PG8_BAR;
        PG8_WAIT_V(4); PG8_BAR;
        PG8_STAGE(PG8_SB(1, 0), cB + kstep, voffB); PG8_STAGE(PG8_SA(1, 0), cA + kstep, voffA); PG8_STAGE(PG8_SB(1, 1), cB + hstep + kstep, voffB);
        PG8_WAIT_V(6); PG8_BAR;
    }
    for (;;) {
        const bool has_next = S.next(ui + 1, nxt);
        const char* nA = has_next ? (const char*)g.A + (size_t)nxt.pm * tstep : cA; const char* nB = has_next ? (const char*)g.Bt + (size_t)nxt.pn * tstep : cB;
        constexpr int nseg = Epi::MID ? 2 : 1; const int seglen = nt / nseg;
        for (int seg = 0; seg < nseg; ++seg) {
        if constexpr (Epi::MID) { if (seg == 1) E.mid(acc, cur, wr, wc, fr, fq); }
        for (int t = seg * seglen; t < (seg + 1) * seglen; t += 2) {
            const bool last = (t == nt - 2);
            const char* a1 = cA + (size_t)(t + 1) * kstep;
            const char* a2 = last ? nA : cA + (size_t)(t + 2) * kstep; const char* b2 = last ? nB : cB + (size_t)(t + 2) * kstep;
            const char* a3 = a2 + kstep; const char* b3 = b2 + kstep;
            if (last && has_next) S.a_ready(nxt);
            if constexpr (SP2) {
            PG8_LDB(B0, 0, 0); PG8_LDB(B1, 0, 1); PG8_SCHED; PG8_LDA(At, 0, 0); PG8_STAGE(PG8_SA(1, 1), a1 + hstep, voffA);
            PG8_WAIT_V(8); PG8_WAIT_L(0); PG8_BAR; PG8_MMA(0, 0, At, B0); PG8_MMA(0, 1, At, B1); PG8_BAR; PG8_SCHED;
            PG8_LDA(At, 0, 1); PG8_STAGE(PG8_SB(0, 0), b2, voffB); PG8_STAGE(PG8_SB(0, 1), b2 + hstep, voffB); PG8_STAGE(PG8_SA(0, 0), a2, voffA);
            PG8_WAIT_V(8); PG8_WAIT_L(0); PG8_BAR; PG8_MMA(1, 0, At, B0); PG8_MMA(1, 1, At, B1); PG8_BAR; PG8_SCHED;
            PG8_LDB(B0, 1, 0); PG8_LDB(B1, 1, 1); PG8_SCHED; PG8_LDA(At, 1, 0); PG8_STAGE(PG8_SA(0, 1), a2 + hstep, voffA);
            PG8_WAIT_V(8); PG8_WAIT_L(0); PG8_BAR; PG8_MMA(0, 0, At, B0); PG8_MMA(0, 1, At, B1); PG8_BAR; PG8_SCHED;
            PG8_LDA(At, 1, 1); PG8_STAGE(PG8_SB(1, 0), b3, voffB); PG8_STAGE(PG8_SB(1, 1), b3 + hstep, voffB); PG8_STAGE(PG8_SA(1, 0), a3, voffA);
            PG8_WAIT_V(8); PG8_WAIT_L(0); PG8_BAR; PG8_MMA(1, 0, At, B0); PG8_MMA(1, 1, At, B1); PG8_BAR; PG8_SCHED;
            } else {
            PG8_LDB(B0, 0, 0); PG8_SCHED; PG8_LDA(At, 0, 0); PG8_STAGE(PG8_SA(1, 1), a1 + hstep, voffA);
            PG8_WAIT_L(8); PG8_BAR; PG8_WAIT_L(0); PG8_MMA(0, 0, At, B0); PG8_BAR; PG8_SCHED;
            PG8_LDB(B1, 0, 1); PG8_STAGE(PG8_SB(0, 0), b2, voffB);
            PG8_BAR; PG8_WAIT_L(0); PG8_MMA(0, 1, At, B1); PG8_BAR;
            PG8_LDA(At, 0, 1); PG8_STAGE(PG8_SA(0, 0), a2, voffA);
            PG8_BAR; PG8_WAIT_L(0); PG8_MMA(1, 0, At, B0); PG8_BAR; PG8_SCHED;
            PG8_STAGE(PG8_SB(0, 1), b2 + hstep, voffB);
            PG8_WAIT_V(6); PG8_BAR; PG8_MMA(1, 1, At, B1); PG8_BAR;
            PG8_LDB(B0, 1, 0); PG8_SCHED; PG8_LDA(At, 1, 0); PG8_STAGE(PG8_SA(0, 1), a2 + hstep, voffA);
            PG8_WAIT_L(8); PG8_BAR; PG8_WAIT_L(0); PG8_MMA(0, 0, At, B0); PG8_BAR; PG8_SCHED;
            PG8_LDB(B1, 1, 1); PG8_STAGE(PG8_SB(1, 0), b3, voffB);
            PG8_BAR; PG8_WAIT_L(0); PG8_MMA(0, 1, At, B1); PG8_BAR;
            PG8_LDA(At, 1, 1); PG8_STAGE(PG8_SA(1, 0), a3, voffA);
            PG8_BAR; PG8_WAIT_L(0); PG8_MMA(1, 0, At, B0); PG8_BAR; PG8_SCHED;
            PG8_STAGE(PG8_SB(1, 1), b3 + hstep, voffB);
            PG8_WAIT_V(6); PG8_BAR; PG8_MMA(1, 1, At, B1); PG8_BAR;
            }
        }
        }
        if constexpr (ALIGN_EPI) { if (wr == 0) PG8_BAR; }
        if constexpr (!Epi::AFTER_DRAIN) { E(acc, cur, wr, wc, fr, fq); S.done(cur); }
        if (!has_next) break;
#pragma unroll
        for (int a = 0; a < 2; ++a)
#pragma unroll
            for (int b = 0; b < 2; ++b)
#pragma unroll
                for (int m = 0; m < 4; ++m)
#pragma unroll
                    for (int n = 0; n < 2; ++n) acc[a][b][m][n] = (f32x4){0.f, 0.f, 0.f, 0.f};
        cur = nxt; cA = nA; cB = nB; ++ui;
        if constexpr (ALIGN_EPI) { if (wr == 1) PG8_BAR; }
    }
    PG8_WAIT_V(0);
    if constexpr (!ALIGN_EPI) { if (wr == 0) PG8_BAR; }
    PG8_BAR;
    if constexpr (Epi::AFTER_DRAIN) { E.fused(acc, cur, wr, wc, fr, fq, lds, wid, lane); S.done(cur); }
#undef PG8_SA
#undef PG8_SB
#undef PG8_STAGE
#undef PG8_LDA
#undef PG8_LDB
#undef PG8_MMA
#undef PG8_WAIT_V
#undef PG8_WAIT_L
#undef PG8_BAR
#undef PG8_SCHED
}
}

typedef unsigned short bf16_t;
typedef float f32x2 __attribute__((ext_vector_type(2)));
typedef float f32x4 __attribute__((ext_vector_type(4)));
typedef float f32x16 __attribute__((ext_vector_type(16)));
typedef short bf16x8 __attribute__((ext_vector_type(8)));
typedef short s16x4 __attribute__((ext_vector_type(4)));
typedef unsigned u32x4 __attribute__((ext_vector_type(4)));
typedef unsigned u32x2 __attribute__((ext_vector_type(2)));
typedef __bf16 bf16x2_t __attribute__((ext_vector_type(2)));
#define LAS __attribute__((address_space(3)))
#define DI __device__ __forceinline__
#define XB_TMO      128
#define XB_XCNT(j)  (256  + 64 * (j))
#define XB_XSUB(j)  (1280 + 64 * (j))
#define XB_XGEN(j)  (2304 + 64 * (j))
#define XB_TOP      3328
#define XB_TOPGEN   3392
#define XCD_BAR_WORDS 3456
#define XB_SPIN_CAP (1u << 18)

__device__ __forceinline__ unsigned xb_ld(unsigned* p)              { return __hip_atomic_load(p, __ATOMIC_RELAXED, __HIP_MEMORY_SCOPE_AGENT); }
__device__ __forceinline__ unsigned xb_add(unsigned* p, unsigned v) { return __hip_atomic_fetch_add(p, v, __ATOMIC_RELAXED, __HIP_MEMORY_SCOPE_AGENT); }
__device__ __forceinline__ unsigned xb_xcc_id() { return (unsigned)__builtin_amdgcn_s_getreg((3 << 11) | 20) & 0xFu; }
#define XB_SPIN(cond, bar) do { unsigned _sp = 0; while (cond) { __builtin_amdgcn_s_sleep(1); \
    if ((++_sp & 255u) == 0u) { if (xb_ld(&(bar)[XB_TMO])) break; if (_sp > XB_SPIN_CAP) { atomicAdd(&(bar)[XB_TMO], 1u); break; } } } } while (0)

struct XcdBarrier {
    unsigned* bar; unsigned x;
    volatile LAS unsigned* st;
};

__device__ __forceinline__ XcdBarrier xcd_barrier_post(unsigned* bar, volatile LAS unsigned* st) {
    XcdBarrier b; b.bar = bar; b.x = xb_xcc_id(); b.st = st;
    if (threadIdx.x == 0) (void)xb_add(&bar[XB_XCNT(b.x)], 1u);
    return b;
}
__device__ __forceinline__ void xcd_barrier_complete(unsigned* bar, unsigned x, unsigned& nloc, unsigned& nx) {
    const unsigned G = gridDim.x * gridDim.y * gridDim.z;
    unsigned sum, cnt, mine, sp = 0u;
    for (;;) {
        sum = 0u; cnt = 0u; mine = 0u;
#pragma unroll
        for (unsigned j = 0; j < 16; ++j) { const unsigned c = xb_ld(&bar[XB_XCNT(j)]); sum += c; cnt += (c > 0u) ? 1u : 0u; mine = (j == x) ? c : mine; }
        if (sum == G) break;
        __builtin_amdgcn_s_sleep(1);
        if ((++sp & 255u) == 0u) { if (xb_ld(&bar[XB_TMO])) break; if (sp > XB_SPIN_CAP) { atomicAdd(&bar[XB_TMO], 1u); break; } }
    }
    nloc = mine > 0u ? mine : 1u; nx = cnt > 0u ? cnt : 1u;
}

__device__ __forceinline__ void xcd_barrier(const XcdBarrier& b) {
    asm volatile("s_waitcnt vmcnt(0)" ::: "memory");
    __syncthreads();
    if (threadIdx.x == 0) {
        unsigned* bar = b.bar;
        __builtin_amdgcn_s_waitcnt(0);
        unsigned nloc = b.st[0], nx = b.st[1];
        if (nloc == 0u) { xcd_barrier_complete(bar, b.x, nloc, nx); b.st[0] = nloc; b.st[1] = nx; }
        const unsigned old = xb_add(&bar[XB_XSUB(b.x)], 1u);
        const unsigned gen = old / nloc;
        if (old + 1u == (gen + 1u) * nloc) {
            __builtin_amdgcn_fence(__ATOMIC_RELEASE, "agent");
            asm volatile("s_waitcnt vmcnt(0)" ::: "memory");
            const unsigned og = xb_add(&bar[XB_TOP], 1u);
            const unsigned tg = og / nx;
            if (og + 1u == (tg + 1u) * nx) xb_add(&bar[XB_TOPGEN], 1u);
            else XB_SPIN(xb_ld(&bar[XB_TOPGEN]) == tg, bar);
            __builtin_amdgcn_fence(__ATOMIC_ACQUIRE, "agent");
            xb_add(&bar[XB_XGEN(b.x)], 1u);
            asm volatile("s_waitcnt vmcnt(0)" ::: "memory");
        } else {
            XB_SPIN(xb_ld(&bar[XB_XGEN(b.x)]) == gen, bar);
            __builtin_amdgcn_fence(__ATOMIC_ACQUIRE, "agent");
            asm volatile("s_waitcnt vmcnt(0)" ::: "memory");
        }
    }
    __syncthreads();
}


constexpr int NT = 32768, T = 2048, D = 2048;
constexpr int SW = 3328, QKVW = 1536, ZGW = 6144;
constexpr size_t MiB = 1ull << 20;
constexpr size_t WS_WINT = 0, WS_WRT = 44 * MiB, WS_WAT = 48 * MiB, WS_WOT = 52 * MiB, WS_WLT = 60 * MiB,
    WS_H = 64 * MiB, WS_PS = 192 * MiB, WS_PQKV = 400 * MiB, WS_LORA = 496 * MiB, WS_AA = 512 * MiB, WS_VT = 640 * MiB,
    WS_OA = 496 * MiB, WS_COEF = 1008 * MiB, WS_PZG = 624 * MiB, WS_ORP = 400 * MiB, WS_TEMP = 64 * MiB, WS_MERGED = 320 * MiB;
constexpr size_t WS_RS = 720 * MiB, WS_KS = 784 * MiB, WS_VS = 848 * MiB, WS_KK = 912 * MiB;
constexpr int LDS_BYTES = 131072 + 256, LDS_XB = 131072;
constexpr size_t WS_XBAR = 1012 * MiB;
constexpr float QSCALE = 0.125f * 1.4426950408889634f;

struct Params {
    const float* x; const float* norm_g; const float* w_in; const float* shift_mu; const float* w0; const float* w_up; const float* a0; const float* a_up;
    const float* k_k; const float* k_a; const float* r_k; const float* gn_w; const float* gn_b; const float* q_norm_g; const float* k_norm_g;
    const float* w_br; const float* w_ba; const float* w_out; const float* fng;
    float* out; unsigned char* ws; int ph_lo, ph_hi;
};

DI int ltid() { int t = threadIdx.x; asm volatile("" : "+v"(t)); return t; }
DI float bf2f(unsigned v) { return __uint_as_float(v << 16); }
DI unsigned cvtpk(float lo, float hi) { f32x2 v = {lo, hi}; bf16x2_t b = __builtin_convertvector(v, bf16x2_t); return __builtin_bit_cast(unsigned, b); }
DI bf16_t f2bf(float f) { return (bf16_t)(cvtpk(f, 0.f) & 0xffffu); }
DI float wave_sum(float v) {
#pragma unroll
    for (int o = 32; o; o >>= 1) v += __shfl_xor(v, o);
    return v;
}
DI float sigm(float x) { return __builtin_amdgcn_rcpf(1.0f + __builtin_amdgcn_exp2f(-1.4426950408889634f * x)); }
DI float siluf(float x) { return x * sigm(x); }
template <int CTRL> DI float dppf(float x) { return __builtin_bit_cast(float, __builtin_amdgcn_update_dpp(0, __builtin_bit_cast(int, x), CTRL, 0xf, 0xf, true)); }
DI float wave_sum_fast(float x) {
    x += dppf<0xB1>(x); x += dppf<0x4E>(x); x += dppf<0x124>(x); x += dppf<0x128>(x);
    const int xi = __builtin_bit_cast(int, x);
    const float s0 = __builtin_bit_cast(float, __builtin_amdgcn_readlane(xi, 0)), s1 = __builtin_bit_cast(float, __builtin_amdgcn_readlane(xi, 16));
    const float s2 = __builtin_bit_cast(float, __builtin_amdgcn_readlane(xi, 32)), s3 = __builtin_bit_cast(float, __builtin_amdgcn_readlane(xi, 48));
    return (s0 + s1) + (s2 + s3);
}

DI float sum8(float x) { x += dppf<0xB1>(x); x += dppf<0x4E>(x); x += dppf<0x141>(x); return x; }
DI void unpack8(const u32x4 w, float (&f)[8]) {
#pragma unroll
    for (int i = 0; i < 4; ++i) { f[2 * i] = __uint_as_float(w[i] << 16); f[2 * i + 1] = __uint_as_float(w[i] & 0xffff0000u); }
}
DI u32x4 pack8(const float (&f)[8]) { u32x4 w; w.x = cvtpk(f[0], f[1]); w.y = cvtpk(f[2], f[3]); w.z = cvtpk(f[4], f[5]); w.w = cvtpk(f[6], f[7]); return w; }
using pg8::Unit;
struct EpiSplit {
    static constexpr bool PERM = true, AFTER_DRAIN = false, MID = false;
    bf16_t* ps; bf16_t* pq;
    DI void operator()(const f32x4 (&acc)[2][2][4][2], const Unit& u, int wr, int wc, int fr, int fq) const {
        int colt = u.pn * 256; bf16_t* base = ps; int ldc = SW;
        if (colt >= SW) { base = pq; ldc = QKVW; colt -= SW; }
        const int row0 = u.pm * 256 + wr * 64 + fr, col0 = colt + wc * 32 + 8 * fq;
#pragma unroll
        for (int ai = 0; ai < 2; ++ai)
#pragma unroll
            for (int m = 0; m < 4; ++m) { bf16_t* rowp = base + (size_t)(row0 + ai * 128 + m * 16) * ldc + col0;
#pragma unroll
                for (int bj = 0; bj < 2; ++bj) { const f32x4 v0 = acc[ai][bj][m][0], v1 = acc[ai][bj][m][1]; u32x4 w;
                    w.x = cvtpk(v0[0], v0[1]); w.y = cvtpk(v0[2], v0[3]); w.z = cvtpk(v1[0], v1[1]); w.w = cvtpk(v1[2], v1[3]);
                    *(u32x4*)(rowp + bj * 128) = w; } }
    }
};
struct EpiPlain {
    static constexpr bool PERM = true, AFTER_DRAIN = false, MID = false;
    bf16_t* o; int ldc;
    DI void operator()(const f32x4 (&acc)[2][2][4][2], const Unit& u, int wr, int wc, int fr, int fq) const {
        const int row0 = u.pm * 256 + wr * 64 + fr, col0 = u.pn * 256 + wc * 32 + 8 * fq;
#pragma unroll
        for (int ai = 0; ai < 2; ++ai)
#pragma unroll
            for (int m = 0; m < 4; ++m) { bf16_t* rowp = o + (size_t)(row0 + ai * 128 + m * 16) * ldc + col0;
#pragma unroll
                for (int bj = 0; bj < 2; ++bj) { const f32x4 v0 = acc[ai][bj][m][0], v1 = acc[ai][bj][m][1]; u32x4 w;
                    w.x = cvtpk(v0[0], v0[1]); w.y = cvtpk(v0[2], v0[3]); w.z = cvtpk(v1[0], v1[1]); w.w = cvtpk(v1[2], v1[3]);
                    *(u32x4*)(rowp + bj * 128) = w; } }
    }
};
struct EpiLora {
    static constexpr bool PERM = false, AFTER_DRAIN = false, MID = false;
    bf16_t* dec; bf16_t* aa; const float* w0; const float* a0;
    DI void operator()(const f32x4 (&acc)[2][2][4][2], const Unit& u, int wr, int wc, int fr, int fq) const {
        const int kind = u.pn >> 2, dir = kind & 1;
        const int row0 = u.pm * 256 + wr * 64 + fr, cc0 = (u.pn & 3) * 256 + wc * 32 + 4 * fq;
        const float* bias = (kind < 2 ? w0 : a0) + dir * 1024;
#pragma unroll
        for (int bj = 0; bj < 2; ++bj)
#pragma unroll
            for (int n = 0; n < 2; ++n) { const int cc = cc0 + bj * 128 + 16 * n; const f32x4 bv = *(const f32x4*)(bias + cc);
#pragma unroll
                for (int ai = 0; ai < 2; ++ai)
#pragma unroll
                    for (int m = 0; m < 4; ++m) { const size_t row = (size_t)dir * NT + row0 + ai * 128 + m * 16; const f32x4 v = acc[ai][bj][m][n] + bv;
                        if (kind < 2) { u32x2 w;
                            w.x = cvtpk(-0.8750256610856424f * sigm(v[0]), -0.8750256610856424f * sigm(v[1])); w.y = cvtpk(-0.8750256610856424f * sigm(v[2]), -0.8750256610856424f * sigm(v[3]));
                            *(u32x2*)(dec + row * 1024 + cc) = w;
                        } else { u32x2 w; w.x = cvtpk(sigm(v[0]), sigm(v[1])); w.y = cvtpk(sigm(v[2]), sigm(v[3])); *(u32x2*)(aa + row * 1024 + cc) = w; } } }
    }
};
struct EpiGateR {
    static constexpr bool PERM = true, AFTER_DRAIN = false, MID = false;
    bf16_t* temp; const bf16_t* pzg;
    DI void operator()(const f32x4 (&acc)[2][2][4][2], const Unit& u, int wr, int wc, int fr, int fq) const {
        const int row0 = u.pm * 256 + wr * 64 + fr, c0 = u.pn * 256 + wc * 32 + 8 * fq;
#pragma unroll
        for (int ai = 0; ai < 2; ++ai)
#pragma unroll
            for (int m = 0; m < 4; ++m) { const size_t row = row0 + ai * 128 + m * 16;
#pragma unroll
                for (int bj = 0; bj < 2; ++bj) { const int c = c0 + bj * 128; const u32x4 g = *(const u32x4*)(pzg + row * ZGW + 2048 + c);
                    const f32x4 v0 = acc[ai][bj][m][0], v1 = acc[ai][bj][m][1]; u32x4 w;
                    w.x = cvtpk(v0[0] * sigm(bf2f(g.x & 0xffffu)), v0[1] * sigm(bf2f(g.x >> 16)));
                    w.y = cvtpk(v0[2] * sigm(bf2f(g.y & 0xffffu)), v0[3] * sigm(bf2f(g.y >> 16)));
                    w.z = cvtpk(v1[0] * sigm(bf2f(g.z & 0xffffu)), v1[1] * sigm(bf2f(g.z >> 16)));
                    w.w = cvtpk(v1[2] * sigm(bf2f(g.w & 0xffffu)), v1[3] * sigm(bf2f(g.w >> 16)));
                    *(u32x4*)(temp + row * 2048 + c) = w; } }
    }
};
struct EpiGateA {
    static constexpr bool PERM = true, AFTER_DRAIN = false, MID = false;
    const bf16_t* temp; const bf16_t* pzg; bf16_t* merged;
    DI void operator()(const f32x4 (&acc)[2][2][4][2], const Unit& u, int wr, int wc, int fr, int fq) const {
        const int row0 = u.pm * 256 + wr * 64 + fr, c0 = u.pn * 256 + wc * 32 + 8 * fq;
#pragma unroll
        for (int ai = 0; ai < 2; ++ai)
#pragma unroll
            for (int m = 0; m < 4; ++m) { const size_t row = row0 + ai * 128 + m * 16;
#pragma unroll
                for (int bj = 0; bj < 2; ++bj) { const int c = c0 + bj * 128; const u32x4 g = *(const u32x4*)(pzg + row * ZGW + 4096 + c);
                    const u32x4 t = *(const u32x4*)(temp + row * 2048 + c); const f32x4 v0 = acc[ai][bj][m][0], v1 = acc[ai][bj][m][1]; u32x4 w;
                    w.x = cvtpk(bf2f(t.x & 0xffffu) + v0[0] * sigm(bf2f(g.x & 0xffffu)), bf2f(t.x >> 16) + v0[1] * sigm(bf2f(g.x >> 16)));
                    w.y = cvtpk(bf2f(t.y & 0xffffu) + v0[2] * sigm(bf2f(g.y & 0xffffu)), bf2f(t.y >> 16) + v0[3] * sigm(bf2f(g.y >> 16)));
                    w.z = cvtpk(bf2f(t.z & 0xffffu) + v1[0] * sigm(bf2f(g.z & 0xffffu)), bf2f(t.z >> 16) + v1[1] * sigm(bf2f(g.z >> 16)));
                    w.w = cvtpk(bf2f(t.w & 0xffffu) + v1[2] * sigm(bf2f(g.w & 0xffffu)), bf2f(t.w >> 16) + v1[3] * sigm(bf2f(g.w >> 16)));
                    *(u32x4*)(merged + row * 2048 + c) = w; } }
    }
};
struct EpiMerged {
    static constexpr bool PERM = true, AFTER_DRAIN = false, MID = true;
    const bf16_t* pzg; bf16_t* merged;
    DI void mid(f32x4 (&acc)[2][2][4][2], const Unit& u, int wr, int wc, int fr, int fq) const {
        int row0 = u.pm * 256 + wr * 64 + fr, c0 = u.pn * 256 + wc * 32 + 8 * fq;
        asm volatile("" : "+v"(row0), "+v"(c0));
#pragma unroll
        for (int ai = 0; ai < 2; ++ai)
#pragma unroll
            for (int m = 0; m < 4; ++m) { const size_t row = row0 + ai * 128 + m * 16;
#pragma unroll
                for (int bj = 0; bj < 2; ++bj) { const int c = c0 + bj * 128; const u32x4 gr = *(const u32x4*)(pzg + row * ZGW + 2048 + c), ga = *(const u32x4*)(pzg + row * ZGW + 4096 + c);
#pragma unroll
                    for (int i = 0; i < 4; ++i) {
                        const float r0 = sigm(bf2f(gr[i] & 0xffffu)) * (1.0f + __builtin_amdgcn_exp2f(-1.4426950408889634f * bf2f(ga[i] & 0xffffu)));
                        const float r1 = sigm(bf2f(gr[i] >> 16)) * (1.0f + __builtin_amdgcn_exp2f(-1.4426950408889634f * bf2f(ga[i] >> 16)));
                        acc[ai][bj][m][i >> 1][(i & 1) * 2] *= r0; acc[ai][bj][m][i >> 1][(i & 1) * 2 + 1] *= r1; } }
                if (m == 3) __builtin_amdgcn_sched_barrier(0); }
    }
    DI void operator()(const f32x4 (&acc)[2][2][4][2], const Unit& u, int wr, int wc, int fr, int fq) const {
        const int row0 = u.pm * 256 + wr * 64 + fr, c0 = u.pn * 256 + wc * 32 + 8 * fq;
#pragma unroll
        for (int ai = 0; ai < 2; ++ai)
#pragma unroll
            for (int m = 0; m < 4; ++m) { const size_t row = row0 + ai * 128 + m * 16;
#pragma unroll
                for (int bj = 0; bj < 2; ++bj) { const int c = c0 + bj * 128; const u32x4 g = *(const u32x4*)(pzg + row * ZGW + 4096 + c);
                    const f32x4 v0 = acc[ai][bj][m][0], v1 = acc[ai][bj][m][1]; u32x4 w;
                    w.x = cvtpk(v0[0] * sigm(bf2f(g.x & 0xffffu)), v0[1] * sigm(bf2f(g.x >> 16)));
                    w.y = cvtpk(v0[2] * sigm(bf2f(g.y & 0xffffu)), v0[3] * sigm(bf2f(g.y >> 16)));
                    w.z = cvtpk(v1[0] * sigm(bf2f(g.z & 0xffffu)), v1[1] * sigm(bf2f(g.z >> 16)));
                    w.w = cvtpk(v1[2] * sigm(bf2f(g.w & 0xffffu)), v1[3] * sigm(bf2f(g.w >> 16)));
                    *(u32x4*)(merged + row * 2048 + c) = w; } }
    }
};
struct EpiOut {
    static constexpr bool PERM = true, AFTER_DRAIN = false, MID = false;
    bf16_t* y;
    DI void operator()(const f32x4 (&acc)[2][2][4][2], const Unit& u, int wr, int wc, int fr, int fq) const {
        const int row0 = u.pm * 256 + wr * 64 + fr, c0 = u.pn * 256 + wc * 32 + 8 * fq;
#pragma unroll
        for (int ai = 0; ai < 2; ++ai)
#pragma unroll
            for (int m = 0; m < 4; ++m) { bf16_t* rowp = y + (size_t)(row0 + ai * 128 + m * 16) * 2048 + c0;
#pragma unroll
                for (int bj = 0; bj < 2; ++bj) { const f32x4 v0 = acc[ai][bj][m][0], v1 = acc[ai][bj][m][1]; u32x4 w;
                    w.x = cvtpk(v0[0], v0[1]); w.y = cvtpk(v0[2], v0[3]); w.z = cvtpk(v1[0], v1[1]); w.w = cvtpk(v1[2], v1[3]);
                    *(u32x4*)(rowp + bj * 128) = w; } }
    }
};

DI void transpose_tiles(const float* __restrict__ W, int K, int N, bf16_t* __restrict__ WT, int remap, LAS float* tile, int ldw) {
    const int tid = ltid(); const int ntn = N / 64, ntiles = ntn * (K / 64);
    for (int ti = blockIdx.x; ti < ntiles; ti += gridDim.x) {
        const int k0 = (ti / ntn) * 64, n0 = (ti % ntn) * 64;
#pragma unroll
        for (int i = 0; i < 2; ++i) { const int idx = tid + 512 * i, kk = idx >> 4, n4 = (idx & 15) * 4; const f32x4 v = *(const f32x4*)(W + (size_t)(k0 + kk) * N + n0 + n4);
            tile[kk * 65 + n4] = v[0]; tile[kk * 65 + n4 + 1] = v[1]; tile[kk * 65 + n4 + 2] = v[2]; tile[kk * 65 + n4 + 3] = v[3]; }
        __syncthreads();
        { const int nn = tid >> 3, kg = (tid & 7) * 8; int n = n0 + nn;
            if (remap) { if (n >= 3328 && n < 4352) n += 1536; else if (n >= 4352 && n < 5888) n -= 1024; }
            float f[8];
#pragma unroll
            for (int i = 0; i < 8; ++i) f[i] = tile[(kg + i) * 65 + nn];
            *(u32x4*)(WT + (size_t)n * ldw + k0 + kg) = pack8(f); }
        __syncthreads();
    }
}
DI void p0_prologue(const Params& P, LAS unsigned char* lds) {
    const int tid = ltid(), lane = tid & 63, wid = tid >> 6;
    const int gw = blockIdx.x * 8 + wid, nw = gridDim.x * 8;
    bf16_t* H = (bf16_t*)(P.ws + WS_H);
    for (int row = gw; row < NT; row += nw) {
        const f32x4* xr = (const f32x4*)(P.x + (size_t)row * D);
        f32x4 v[8]; float ss = 0.f;
#pragma unroll
        for (int i = 0; i < 8; ++i) { v[i] = __builtin_nontemporal_load(xr + i * 64 + lane); ss += v[i][0] * v[i][0] + v[i][1] * v[i][1] + v[i][2] * v[i][2] + v[i][3] * v[i][3]; }
        ss = wave_sum(ss); const float rs = rsqrtf(ss * (1.0f / D) + 1e-6f);
#pragma unroll
        for (int i = 0; i < 8; ++i) { const f32x4 g = ((const f32x4*)P.norm_g)[i * 64 + lane]; u32x2 w;
            w.x = cvtpk(v[i][0] * rs * g[0], v[i][1] * rs * g[1]); w.y = cvtpk(v[i][2] * rs * g[2], v[i][3] * rs * g[3]);
            *(u32x2*)(H + (size_t)row * D + (i * 64 + lane) * 4) = w; }
    }
    LAS float* tile = (LAS float*)lds;
    transpose_tiles(P.w_in, 2048, 11008, (bf16_t*)(P.ws + WS_WINT), 1, tile, 2048);
    transpose_tiles(P.w_br, 1024, 2048, (bf16_t*)(P.ws + WS_WRT), 0, tile, 2048);
    transpose_tiles(P.w_ba, 1024, 2048, (bf16_t*)(P.ws + WS_WRT) + 1024, 0, tile, 2048);
    transpose_tiles(P.w_out, 2048, 2048, (bf16_t*)(P.ws + WS_WOT), 0, tile, 2048);
    bf16_t* WL = (bf16_t*)(P.ws + WS_WLT);
    for (int idx = blockIdx.x * 512 + tid; idx < 4096 * 256; idx += gridDim.x * 512) {
        const int n = idx >> 8, k = idx & 255, kind = n >> 10, cc = n & 1023, kb = k >> 6, r = k & 63; float val = 0.f;
        if (kb == kind) val = (kind < 2) ? P.w_up[(size_t)(kind * 64 + r) * 1024 + cc] : P.a_up[(size_t)((kind - 2) * 64 + r) * 1024 + cc];
        WL[idx] = f2bf(val);
    }
}

struct QkSlot { u32x4 x; f32x4 g0, g1; };
DI void qk_slot_load(const Params& P, int si, int lane, QkSlot& S) {
    const int tok = si / 3, part = si - tok * 3, l8 = lane & 7;
    const bf16_t* row = (const bf16_t*)(P.ws + WS_PQKV) + (size_t)tok * QKVW + part * 512 + lane * 8;
    S.x = (part < 2 || lane < 32) ? *(const u32x4*)row : (u32x4){0u, 0u, 0u, 0u};
    const float* g = (part < 2 ? P.q_norm_g : P.k_norm_g) + l8 * 8;
    S.g0 = *(const f32x4*)g; S.g1 = *(const f32x4*)(g + 4);
}
DI void qk_slot_process(const Params& P, int si, int lane, const QkSlot& S) {
    const int tok = si / 3, part = si - tok * 3, t = tok & (T - 1); int l8 = lane & 7; asm volatile("" : "+v"(l8));
    const float pos = (l8 < 4) ? (float)(t >> 6) : (float)(t & 63);
    const float gs = part < 2 ? QSCALE : 1.0f;
    float f[8]; unpack8(S.x, f); float ss = 0.f;
#pragma unroll
    for (int i = 0; i < 8; ++i) ss += f[i] * f[i];
    ss = sum8(ss); const float rs = rsqrtf(ss * (1.0f / 64.0f) + 1e-6f) * gs;
    float o[8];
#pragma unroll
    for (int i = 0; i < 4; ++i) {
        const float frq = exp2f(-(float)(2 * ((l8 * 4 + i) & 15)) * (13.287712379549449f / 32.0f)) * 0.15915494309189535f;
        float rev = pos * frq; rev -= floorf(rev); const float sn = __builtin_amdgcn_sinf(rev), cs = __builtin_amdgcn_cosf(rev);
        const float ga = i < 2 ? S.g0[2 * i] : S.g1[2 * i - 4], gb = i < 2 ? S.g0[2 * i + 1] : S.g1[2 * i - 3];
        const float a0 = f[2 * i] * rs * ga, a1 = f[2 * i + 1] * rs * gb;
        o[2 * i] = a0 * cs - a1 * sn; o[2 * i + 1] = a0 * sn + a1 * cs; }
    bf16_t* row = (bf16_t*)(P.ws + WS_PQKV) + (size_t)tok * QKVW + part * 512 + lane * 8;
    if (part < 2 || lane < 32) *(u32x4*)row = pack8(o);
}

DI void p2_prep(const Params& P, LAS unsigned char* lds) {
    const int tid = ltid(), lane = tid & 63, wid = tid >> 6;
    const int gw = blockIdx.x * 8 + wid, nw = gridDim.x * 8;
    const bf16_t* PS = (const bf16_t*)(P.ws + WS_PS);
    const u32x4 zero4 = {0u, 0u, 0u, 0u};
    {
        const int half = gw & 1, c0 = half * 512 + lane * 8;
        bf16_t* RS = (bf16_t*)(P.ws + WS_RS); bf16_t* KS = (bf16_t*)(P.ws + WS_KS); bf16_t* VS = (bf16_t*)(P.ws + WS_VS); bf16_t* KK = (bf16_t*)(P.ws + WS_KK);
        float m0[3][8], m1[3][8], kkc[8];
#pragma unroll
        for (int v = 0; v < 3; ++v)
#pragma unroll
            for (int i = 0; i < 8; ++i) { m0[v][i] = P.shift_mu[v * 1024 + c0 + i]; m1[v][i] = P.shift_mu[SW + v * 1024 + c0 + i]; }
#pragma unroll
        for (int i = 0; i < 8; ++i) kkc[i] = P.k_k[c0 + i];
        bf16_t* LORA = (bf16_t*)(P.ws + WS_LORA);
        const int cl = 3072 + half * 128 + lane * 2;
        const float ml0a = P.shift_mu[cl], ml0b = P.shift_mu[cl + 1], ml1a = P.shift_mu[SW + cl], ml1b = P.shift_mu[SW + cl + 1];
        for (int g4 = gw >> 1; g4 < NT / 4; g4 += nw >> 1) {
            const int tok0 = g4 * 4, t0 = tok0 & (T - 1);
            u32x4 rw[6][3]; unsigned lw[6];
#pragma unroll
            for (int r = 0; r < 6; ++r) { const int t = t0 - 1 + r; const bool ok = (t >= 0) && (t < T); const unsigned x = *(const unsigned*)(PS + (size_t)(ok ? tok0 - 1 + r : tok0) * SW + cl); lw[r] = ok ? x : 0u; }
#pragma unroll
            for (int r = 0; r < 6; ++r) { const int t = t0 - 1 + r; const bool ok = (t >= 0) && (t < T); const bf16_t* p = PS + (size_t)(ok ? tok0 - 1 + r : tok0) * SW + c0;
#pragma unroll
                for (int v = 0; v < 3; ++v) { const u32x4 x = *(const u32x4*)(p + v * 1024); rw[r][v] = ok ? x : zero4; } }
#pragma unroll
            for (int q = 0; q < 4; ++q) {
                float sh[3][8];
#pragma unroll
                for (int v = 0; v < 3; ++v) { float pv[8], y[8], nx[8]; unpack8(rw[q][v], pv); unpack8(rw[q + 1][v], y); unpack8(rw[q + 2][v], nx);
#pragma unroll
                    for (int i = 0; i < 8; ++i) sh[v][i] = y[i] + m0[v][i] * (pv[i] - y[i]) + m1[v][i] * (nx[i] - y[i]); }
                float kk[8]; float ss = 0.f;
#pragma unroll
                for (int i = 0; i < 8; ++i) { kk[i] = sh[1][i] * kkc[i]; ss += kk[i] * kk[i]; }
                ss = sum8(ss); const float rn = rsqrtf(fmaxf(ss, 1e-24f));
#pragma unroll
                for (int i = 0; i < 8; ++i) kk[i] *= rn;
                const size_t o = (size_t)(tok0 + q) * 1024 + c0;
                *(u32x4*)(RS + o) = pack8(sh[0]); *(u32x4*)(KS + o) = pack8(sh[1]); *(u32x4*)(VS + o) = pack8(sh[2]); *(u32x4*)(KK + o) = pack8(kk);
                { const float pa = bf2f(lw[q] & 0xffffu), pb_ = bf2f(lw[q] >> 16), ya = bf2f(lw[q + 1] & 0xffffu), yb = bf2f(lw[q + 1] >> 16), na_ = bf2f(lw[q + 2] & 0xffffu), nb = bf2f(lw[q + 2] >> 16);
                  float sa_ = ya + ml0a * (pa - ya) + ml1a * (na_ - ya), sb_ = yb + ml0b * (pb_ - yb) + ml1b * (nb - yb);
                  if (half == 0) { sa_ = 1.0f - 2.0f * __builtin_amdgcn_rcpf(1.0f + __builtin_amdgcn_exp2f(2.8853900817779268f * sa_)); sb_ = 1.0f - 2.0f * __builtin_amdgcn_rcpf(1.0f + __builtin_amdgcn_exp2f(2.8853900817779268f * sb_)); }
                  *(unsigned*)(LORA + (size_t)(tok0 + q) * 256 + half * 128 + lane * 2) = cvtpk(sa_, sb_); }
            }
        }
    }
    bf16_t* PQ = (bf16_t*)(P.ws + WS_PQKV);
}

struct G5 { f32x4 w, b, e, r, k; };
DI void p3a_scan(const Params& P, LAS unsigned char* lds, float* OB) {
    const int tid = ltid(), lane = tid & 63, wid = __builtin_amdgcn_readfirstlane(tid >> 6);
    constexpr int BS = 8, REC = 1536, K0OFF = BS * REC, BUF = BS * REC + 256, CH_LDS = 2 * BUF, NBATCH = T / BS;
    const bool scanner = wid < 4;
    if (scanner) __builtin_amdgcn_s_setprio(3);
    const int cw = (wid & 3) >> 1, part = wid & 1;
    LAS unsigned char* L = lds + cw * CH_LDS;
    const bf16_t* PS = (const bf16_t*)(P.ws + WS_PS);
    const bf16_t* AA = (const bf16_t*)(P.ws + WS_AA);
    const bf16_t* DEC = (const bf16_t*)P.out; float* COEF = (float*)(P.ws + WS_COEF);
    int qsi = blockIdx.x * 4 + (wid & 3); const int npw = gridDim.x * 4;
    for (int chain0 = blockIdx.x * 2; chain0 < 512; chain0 += gridDim.x * 2) {
        const int chain = chain0 + cw;
        const int dir = chain & 1, bh = chain >> 1, h = bh & 15, b = bh >> 4;
        const int tstep = dir ? -1 : 1, t0 = dir ? T - 1 : 0;
        const size_t tokbase = (size_t)b * T;
        if (!scanner) {
            QkSlot QS; int qcur = -1;
            const int c = h * 64 + lane;
            const float kac = P.k_a[c], rkc = P.r_k[c];
            const size_t cb = tokbase * 1024 + c;
            const bf16_t* rsb = (const bf16_t*)(P.ws + WS_RS) + cb; const bf16_t* ksb = (const bf16_t*)(P.ws + WS_KS) + cb;
            const bf16_t* vsb = (const bf16_t*)(P.ws + WS_VS) + cb; const bf16_t* kkb = (const bf16_t*)(P.ws + WS_KK) + cb;
            const bf16_t* aab = AA + (size_t)dir * NT * 1024 + cb;
            const bf16_t* decb = DEC + (size_t)dir * NT * 1024 + cb;
            float* coefb = COEF + ((size_t)dir * NT + tokbase) * 16 + h;
            const int woff = (lane >> 2) * 80 + (lane & 3) * 4;
            unsigned short l_r[4], l_k[4], l_v[4], l_kk[4], na[4], nwv[4];
#define PREP_LOAD(bt_) do { _Pragma("unroll") for (int jj = 0; jj < 4; ++jj) { const int s = (bt_) * BS + part * 4 + jj; const int to = (t0 + tstep * s) * 1024; \
                l_r[jj] = rsb[to]; l_k[jj] = ksb[to]; l_v[jj] = vsb[to]; l_kk[jj] = kkb[to]; na[jj] = aab[to]; nwv[jj] = decb[to]; } } while (0)
#define PREP_DO(bt_) do { LAS unsigned char* Bf = L + ((bt_) & 1) * BUF; _Pragma("unroll") for (int jj = 0; jj < 4; ++jj) { const int j = part * 4 + jj; const int s = (bt_) * BS + j; const int t = t0 + tstep * s; \
                const float rs = bf2f(l_r[jj]), ks = bf2f(l_k[jj]), vs = bf2f(l_v[jj]), kk = bf2f(l_kk[jj]); \
                const float a = bf2f(na[jj]), w = __builtin_amdgcn_exp2f(bf2f(nwv[jj])); const float bb = kk * a, ke = ks * (1.0f + (a - 1.0f) * kac); \
                const float cf = wave_sum_fast(rs * ke * rkc); if (lane == 0) coefb[t * 16] = cf; \
                LAS unsigned char* R = Bf + j * REC; \
                *(LAS float*)(R + woff) = w; *(LAS float*)(R + woff + 16) = bb; *(LAS float*)(R + woff + 32) = ke; *(LAS float*)(R + woff + 48) = rs; *(LAS float*)(R + 1280 + lane * 4) = vs; \
                if (j == 0) *(LAS float*)(Bf + K0OFF + lane * 4) = -kk; else *(LAS float*)(R - REC + woff + 64) = -kk; } } while (0)
            PREP_LOAD(0); PREP_DO(0); PREP_LOAD(1);
            __syncthreads();
            for (int bt = 0; bt < NBATCH; ++bt) {
                if (bt + 1 < NBATCH) { PREP_DO(bt + 1); if (bt + 2 < NBATCH) PREP_LOAD(bt + 2); }
                if (bt & 1) { if (qcur >= 0) { qk_slot_process(P, qcur, lane, QS); qcur = -1; } }
                else if (qsi < 3 * NT) { qk_slot_load(P, qsi, lane, QS); qcur = qsi; qsi += npw; }
                __syncthreads();
            }
            if (qcur >= 0) qk_slot_process(P, qcur, lane, QS);
            if (chain0 + (int)gridDim.x * 2 >= 512) for (; qsi < 3 * NT; qsi += npw) { qk_slot_load(P, qsi, lane, QS); qk_slot_process(P, qsi, lane, QS); }
#undef PREP_LOAD
#undef PREP_DO
        } else {
            const int kq = lane & 3, rsl = lane >> 2;
            const int rowA = part * 32 + rsl, rowB = rowA + 16;
            bf16_t* ob = (bf16_t*)OB + (size_t)2 * NT * 1024 + ((size_t)dir * NT + tokbase) * 1024 + h * 64;
            const int roff = kq * 320;
            LAS unsigned char* OW = lds + 102400 + wid * 4096;
            f32x2 SA[8], SB[8];
#pragma unroll
            for (int i = 0; i < 8; ++i) { SA[i] = (f32x2){0.f, 0.f}; SB[i] = (f32x2){0.f, 0.f}; }
            __syncthreads();
            for (int bt = 0; bt < NBATCH; ++bt) {
                const LAS unsigned char* Bf = L + (bt & 1) * BUF;
                f32x2 snA = {0.f, 0.f}, snB = {0.f, 0.f};
#pragma unroll
                for (int i = 0; i < 4; ++i) { const f32x4 k4 = *(const LAS f32x4*)(Bf + K0OFF + kq * 64 + i * 16);
                    snA += SA[2 * i] * k4.xy; snA += SA[2 * i + 1] * k4.zw; snB += SB[2 * i] * k4.xy; snB += SB[2 * i + 1] * k4.zw; }
                G5 buf[2][4];
#define SCAN_LDS(B_, j_) do { _Pragma("unroll") for (int i = 0; i < 4; ++i) { const LAS unsigned char* p_ = Bf + (j_) * REC + roff + i * 80; (B_)[i].w = *(const LAS f32x4*)(p_); (B_)[i].b = *(const LAS f32x4*)(p_ + 16); \
                    (B_)[i].e = *(const LAS f32x4*)(p_ + 32); (B_)[i].r = *(const LAS f32x4*)(p_ + 48); (B_)[i].k = *(const LAS f32x4*)(p_ + 64); } } while (0)
#define SCAN_LDS_H(B_, j_, i0_) do { _Pragma("unroll") for (int i = (i0_); i < (i0_) + 2; ++i) { const LAS unsigned char* p_ = Bf + (j_) * REC + roff + i * 80; (B_)[i].w = *(const LAS f32x4*)(p_); (B_)[i].b = *(const LAS f32x4*)(p_ + 16); \
                    (B_)[i].e = *(const LAS f32x4*)(p_ + 32); (B_)[i].r = *(const LAS f32x4*)(p_ + 48); (B_)[i].k = *(const LAS f32x4*)(p_ + 64); } } while (0)
                SCAN_LDS(buf[0], 0);
                float vA = *(const LAS float*)(Bf + 1280 + rowA * 4), vB = *(const LAS float*)(Bf + 1280 + rowB * 4);
#pragma unroll
                for (int j = 0; j < BS; ++j) {
                    float saA = snA.x + snA.y, saB = snB.x + snB.y;
                    saA += dppf<0xB1>(saA); saB += dppf<0xB1>(saB); saA += dppf<0x4E>(saA); saB += dppf<0x4E>(saB);
                    const f32x2 sa2A = {saA, saA}, sa2B = {saB, saB}, v2A = {vA, vA}, v2B = {vB, vB};
                    if (j + 1 < BS) { SCAN_LDS_H(buf[(j + 1) & 1], j + 1, 0); vA = *(const LAS float*)(Bf + (j + 1) * REC + 1280 + rowA * 4); vB = *(const LAS float*)(Bf + (j + 1) * REC + 1280 + rowB * 4); }
                    __builtin_amdgcn_sched_barrier(0);
                    f32x2 oA = {0.f, 0.f}, oB = {0.f, 0.f}; snA = (f32x2){0.f, 0.f}; snB = (f32x2){0.f, 0.f};
#pragma unroll
                    for (int i = 0; i < 4; ++i) {
                        if (i == 2) { __builtin_amdgcn_sched_barrier(0); if (j + 1 < BS) SCAN_LDS_H(buf[(j + 1) & 1], j + 1, 2); __builtin_amdgcn_sched_barrier(0); }
                        const G5& B = buf[j & 1][i];
                        f32x2 ta = v2A * B.e.xy; ta = sa2A * B.b.xy + ta; SA[2 * i] = SA[2 * i] * B.w.xy + ta; oA += SA[2 * i] * B.r.xy;
                        f32x2 tb = v2B * B.e.xy; tb = sa2B * B.b.xy + tb; SB[2 * i] = SB[2 * i] * B.w.xy + tb; oB += SB[2 * i] * B.r.xy;
                        f32x2 tc = v2A * B.e.zw; tc = sa2A * B.b.zw + tc; SA[2 * i + 1] = SA[2 * i + 1] * B.w.zw + tc; oA += SA[2 * i + 1] * B.r.zw;
                        f32x2 td = v2B * B.e.zw; td = sa2B * B.b.zw + td; SB[2 * i + 1] = SB[2 * i + 1] * B.w.zw + td; oB += SB[2 * i + 1] * B.r.zw;
                        if (j + 1 < BS) { snA += SA[2 * i] * B.k.xy; snB += SB[2 * i] * B.k.xy; snA += SA[2 * i + 1] * B.k.zw; snB += SB[2 * i + 1] * B.k.zw; }
                    }
                    __builtin_amdgcn_sched_barrier(0);
                    *(LAS float*)(OW + j * 512 + rsl * 16 + kq * 4) = oA.x + oA.y; *(LAS float*)(OW + j * 512 + (16 + rsl) * 16 + kq * 4) = oB.x + oB.y;
                }
                __builtin_amdgcn_fence(__ATOMIC_RELEASE, "wavefront"); __builtin_amdgcn_wave_barrier(); __builtin_amdgcn_fence(__ATOMIC_ACQUIRE, "wavefront");
                { const int js = lane >> 3, rg = (lane & 7) * 4;
                  float o4[4];
#pragma unroll
                  for (int i = 0; i < 4; ++i) { const f32x4 p4 = *(const LAS f32x4*)(OW + js * 512 + (rg + i) * 16); o4[i] = (p4.x + p4.y) + (p4.z + p4.w); }
                  const int t = t0 + tstep * (bt * BS + js);
                  u32x2 w; w.x = cvtpk(o4[0], o4[1]); w.y = cvtpk(o4[2], o4[3]);
                  *(u32x2*)(ob + (size_t)t * 1024 + part * 32 + rg) = w; }
                __builtin_amdgcn_fence(__ATOMIC_RELEASE, "wavefront"); __builtin_amdgcn_wave_barrier(); __builtin_amdgcn_fence(__ATOMIC_ACQUIRE, "wavefront");
#undef SCAN_LDS
#undef SCAN_LDS_H
                __syncthreads();
            }
        }
    }
    __builtin_amdgcn_s_setprio(0);
}

typedef short v4i16_t __attribute__((ext_vector_type(4)));
DI s16x4 vtr16(const LAS unsigned char* p) { return __builtin_bit_cast(s16x4, __builtin_amdgcn_ds_read_tr16_b64_v4i16((LAS v4i16_t*)p)); }
DI void p3b_attn(const Params& P, LAS unsigned char* lds) {
    const int tid = ltid(), lane = tid & 63, wid = __builtin_amdgcn_readfirstlane(tid >> 6);
    const int r = lane & 31, hh = lane >> 5;
    constexpr int RSV = 192, TBV = 64 * RSV;
    constexpr int RS = 144, TB = 64 * RS;
    const bf16_t* PQ = (const bf16_t*)(P.ws + WS_PQKV);
    bf16_t* OA = (bf16_t*)(P.ws + WS_OA);
    const int srow = tid >> 3, sseg = tid & 7;
    float mgq = fabsf(P.q_norm_g[lane]), mgk = fabsf(P.k_norm_g[lane]);
#pragma unroll
    for (int o = 32; o; o >>= 1) { mgq = fmaxf(mgq, __shfl_xor(mgq, o)); mgk = fmaxf(mgk, __shfl_xor(mgk, o)); }
    const float negM = -(64.0f * QSCALE * 1.02f) * mgq * mgk;
    f32x16 negM16;
#pragma unroll
    for (int i = 0; i < 16; ++i) negM16[i] = negM;
    const int vcu = (gridDim.x % 8 == 0) ? (int)(blockIdx.x % 8) * (int)(gridDim.x / 8) + (int)(blockIdx.x / 8) : (int)blockIdx.x;
    for (int u = vcu; u < 1024; u += gridDim.x) {
        const int qblk = u & 3, g = (u >> 2) & 3, hkv = (u >> 4) & 3, b = u >> 6, hq = hkv * 4 + g;
        const size_t tokb = (size_t)b * T;
        const int q0 = qblk * 512 + wid * 64;
        bf16x8 qf[2][4];
#pragma unroll
        for (int sub = 0; sub < 2; ++sub) { const bf16_t* qp = PQ + (tokb + q0 + sub * 32 + r) * QKVW + hq * 64 + 8 * hh;
#pragma unroll
            for (int ds = 0; ds < 4; ++ds) qf[sub][ds] = *(const bf16x8*)(qp + ds * 16); }
        const bf16_t* kg = PQ + (tokb + srow) * QKVW + 1024 + hkv * 64 + sseg * 8;
        const bf16_t* vg = PQ + (tokb + srow) * QKVW + 1280 + hkv * 64 + sseg * 8;
        u32x4 kreg = *(const u32x4*)kg, vreg = *(const u32x4*)vg;
        *(LAS u32x4*)(lds + srow * RS + sseg * 16) = kreg; *(LAS u32x4*)(lds + 2 * TB + srow * RSV + sseg * 16) = vreg;
        __syncthreads();
        f32x16 o[2][2];
#pragma unroll
        for (int sub = 0; sub < 2; ++sub)
#pragma unroll
            for (int dt = 0; dt < 2; ++dt)
#pragma unroll
                for (int i = 0; i < 16; ++i) o[sub][dt][i] = 0.f;
        float lsum[2] = {0.f, 0.f};
        for (int kt = 0; kt < 32; ++kt) {
            const int cb = kt & 1;
            if (kt + 1 < 32) { kreg = *(const u32x4*)(kg + (size_t)(kt + 1) * 64 * QKVW); vreg = *(const u32x4*)(vg + (size_t)(kt + 1) * 64 * QKVW); }
            const LAS unsigned char* Kc = lds + cb * TB; const LAS unsigned char* Vc = lds + 2 * TB + cb * TBV;
            f32x16 x[2][2];
#pragma unroll
            for (int sub = 0; sub < 2; ++sub) {
#pragma unroll
                for (int ds = 0; ds < 4; ++ds) {
                    const bf16x8 ka = *(const LAS bf16x8*)(Kc + r * RS + ds * 32 + hh * 16);
                    const bf16x8 kb = *(const LAS bf16x8*)(Kc + (32 + r) * RS + ds * 32 + hh * 16);
                    x[sub][0] = __builtin_amdgcn_mfma_f32_32x32x16_bf16(ka, qf[sub][ds], ds == 0 ? negM16 : x[sub][0], 0, 0, 0);
                    x[sub][1] = __builtin_amdgcn_mfma_f32_32x32x16_bf16(kb, qf[sub][ds], ds == 0 ? negM16 : x[sub][1], 0, 0, 0);
                }
            }
            bf16x8 pb[2][2][2];
#pragma unroll
            for (int sub = 0; sub < 2; ++sub) {
                f32x2 ps2 = {0.f, 0.f};
#pragma unroll
                for (int ks = 0; ks < 2; ++ks) {
#pragma unroll
                    for (int i = 0; i < 16; i += 2) { x[sub][ks][i] = __builtin_amdgcn_exp2f(x[sub][ks][i]); x[sub][ks][i + 1] = __builtin_amdgcn_exp2f(x[sub][ks][i + 1]); ps2 += (f32x2){x[sub][ks][i], x[sub][ks][i + 1]}; }
#pragma unroll
                    for (int s = 0; s < 2; ++s) { u32x4 w;
                        w.x = cvtpk(x[sub][ks][8 * s], x[sub][ks][8 * s + 1]); w.y = cvtpk(x[sub][ks][8 * s + 2], x[sub][ks][8 * s + 3]);
                        w.z = cvtpk(x[sub][ks][8 * s + 4], x[sub][ks][8 * s + 5]); w.w = cvtpk(x[sub][ks][8 * s + 6], x[sub][ks][8 * s + 7]);
                        pb[sub][ks][s] = __builtin_bit_cast(bf16x8, w); }
                }
                lsum[sub] += ps2.x + ps2.y;
            }
#pragma unroll
            for (int ks = 0; ks < 2; ++ks)
#pragma unroll
                for (int s = 0; s < 2; ++s) {
                    const LAS unsigned char* vp_ = Vc + (ks * 32 + 16 * s + 4 * hh + ((lane & 15) >> 2)) * RSV + ((lane >> 4) & 1) * 32 + (lane & 3) * 8;
                    const s16x4 lo0 = vtr16(vp_), hi0 = vtr16(vp_ + 8 * RSV), lo1 = vtr16(vp_ + 64), hi1 = vtr16(vp_ + 8 * RSV + 64);
                    const bf16x8 va0 = __builtin_shufflevector(lo0, hi0, 0, 1, 2, 3, 4, 5, 6, 7), va1 = __builtin_shufflevector(lo1, hi1, 0, 1, 2, 3, 4, 5, 6, 7);
#pragma unroll
                    for (int sub = 0; sub < 2; ++sub) {
                        o[sub][0] = __builtin_amdgcn_mfma_f32_32x32x16_bf16(va0, pb[sub][ks][s], o[sub][0], 0, 0, 0);
                        o[sub][1] = __builtin_amdgcn_mfma_f32_32x32x16_bf16(va1, pb[sub][ks][s], o[sub][1], 0, 0, 0);
                    }
                }
            if (kt + 1 < 32) { *(LAS u32x4*)(lds + (cb ^ 1) * TB + srow * RS + sseg * 16) = kreg; *(LAS u32x4*)(lds + 2 * TB + (cb ^ 1) * TBV + srow * RSV + sseg * 16) = vreg; }
            __syncthreads();
        }
#pragma unroll
        for (int sub = 0; sub < 2; ++sub) {
            float l = lsum[sub]; l += __shfl_xor(l, 32);
            const float inv = 1.0f / l;
            bf16_t* op = OA + (tokb + q0 + sub * 32 + r) * 1024 + hq * 64 + 4 * hh;
#pragma unroll
            for (int gq = 0; gq < 4; ++gq) {
                u32x2 w; w.x = cvtpk(o[sub][0][4 * gq] * inv, o[sub][0][4 * gq + 1] * inv); w.y = cvtpk(o[sub][0][4 * gq + 2] * inv, o[sub][0][4 * gq + 3] * inv); *(u32x2*)(op + 8 * gq) = w;
                u32x2 w2; w2.x = cvtpk(o[sub][1][4 * gq] * inv, o[sub][1][4 * gq + 1] * inv); w2.y = cvtpk(o[sub][1][4 * gq + 2] * inv, o[sub][1][4 * gq + 3] * inv); *(u32x2*)(op + 32 + 8 * gq) = w2;
            }
        }
    }
}

DI void p4_post(const Params& P) {
    const int tid = ltid(), lane = tid & 63, wid = tid >> 6;
    const int gw = blockIdx.x * 8 + wid, nw = gridDim.x * 8;
    const bf16_t* O = (const bf16_t*)P.out + (size_t)2 * NT * 1024; const float* COEF = (const float*)(P.ws + WS_COEF);
    const bf16_t* PS = (const bf16_t*)(P.ws + WS_PS); const bf16_t* PZG = (const bf16_t*)(P.ws + WS_PZG);
    const bf16_t* OA = (const bf16_t*)(P.ws + WS_OA); bf16_t* AC = (bf16_t*)(P.ws + WS_TEMP);
    const int half = gw & 1, c0 = half * 512 + lane * 8, head = c0 >> 6;
    const u32x4 zero4 = {0u, 0u, 0u, 0u};
    float gw_[8], gb_[8], m0[8], m1[8];
#pragma unroll
    for (int i = 0; i < 8; ++i) { gw_[i] = P.gn_w[c0 + i]; gb_[i] = P.gn_b[c0 + i]; m0[i] = P.shift_mu[2048 + c0 + i]; m1[i] = P.shift_mu[SW + 2048 + c0 + i]; }
    for (int g2 = gw >> 1; g2 < NT / 2; g2 += nw >> 1) {
        const int tok0 = g2 * 2, t0 = tok0 & (T - 1);
        u32x4 oa_[2], ob_[2]; u32x4 vr[4], zr[2], za[2], oa[2]; float cf[2];
#pragma unroll
        for (int r = 0; r < 4; ++r) { const int t = t0 - 1 + r; const bool ok = (t >= 0) && (t < T); const u32x4 x = *(const u32x4*)(PS + (size_t)(ok ? tok0 - 1 + r : tok0) * SW + 2048 + c0); vr[r] = ok ? x : zero4; }
#pragma unroll
        for (int q = 0; q < 2; ++q) { const size_t tok = tok0 + q;
            oa_[q] = *(const u32x4*)(O + tok * 1024 + c0); ob_[q] = *(const u32x4*)(O + (NT + tok) * 1024 + c0);
            zr[q] = *(const u32x4*)(PZG + tok * ZGW + c0); za[q] = *(const u32x4*)(PZG + tok * ZGW + 1024 + c0); oa[q] = *(const u32x4*)(OA + tok * 1024 + c0);
            cf[q] = COEF[tok * 16 + head] + COEF[(NT + tok) * 16 + head]; }
#pragma unroll
        for (int q = 0; q < 2; ++q) { const size_t tok = tok0 + q;
            float wkv[8], wk2[8]; float sm = 0.f; unpack8(oa_[q], wkv); unpack8(ob_[q], wk2);
#pragma unroll
            for (int i = 0; i < 8; ++i) { wkv[i] += wk2[i]; sm += wkv[i]; }
            const float mu = sum8(sm) * (1.0f / 64.0f); float sv = 0.f;
#pragma unroll
            for (int i = 0; i < 8; ++i) { wkv[i] -= mu; sv += wkv[i] * wkv[i]; }
            const float rstd = rsqrtf(sum8(sv) * (1.0f / 64.0f) + 64e-5f);
            float pv[8], y[8], nx[8], z1[8], z2[8], av[8], o1[8], o2[8];
            unpack8(vr[q], pv); unpack8(vr[q + 1], y); unpack8(vr[q + 2], nx); unpack8(zr[q], z1); unpack8(za[q], z2); unpack8(oa[q], av);
#pragma unroll
            for (int i = 0; i < 8; ++i) { const float vs = y[i] + m0[i] * (pv[i] - y[i]) + m1[i] * (nx[i] - y[i]);
                o1[i] = (wkv[i] * rstd * gw_[i] + gb_[i] + cf[q] * vs) * siluf(z1[i]); o2[i] = av[i] * siluf(z2[i]); }
            *(u32x4*)(AC + tok * 2048 + c0) = pack8(o1); *(u32x4*)(AC + tok * 2048 + 1024 + c0) = pack8(o2);
        }
    }
}

DI void p7_final(const Params& P) {
    const int tid = ltid(), lane = tid & 63, wid = tid >> 6;
    const int gw = blockIdx.x * 8 + wid, nw = gridDim.x * 8;
    const bf16_t* Y = (const bf16_t*)(P.ws + WS_TEMP);
    f32x4 g[4][2];
#pragma unroll
    for (int i = 0; i < 4; ++i) { g[i][0] = *(const f32x4*)(P.fng + i * 512 + lane * 8); g[i][1] = *(const f32x4*)(P.fng + i * 512 + lane * 8 + 4); }
    for (int r2 = gw; r2 < NT / 2; r2 += nw) {
        u32x4 yv[2][4]; f32x4 xv[2][4][2];
#pragma unroll
        for (int q = 0; q < 2; ++q)
#pragma unroll
            for (int i = 0; i < 4; ++i) { const size_t o_ = (size_t)(r2 * 2 + q) * D + i * 512 + lane * 8; yv[q][i] = *(const u32x4*)(Y + o_); xv[q][i][0] = __builtin_nontemporal_load((const f32x4*)(P.x + o_)); xv[q][i][1] = __builtin_nontemporal_load((const f32x4*)(P.x + o_ + 4)); }
#pragma unroll
        for (int q = 0; q < 2; ++q) {
            float f[4][8]; float ss = 0.f;
#pragma unroll
            for (int i = 0; i < 4; ++i) { unpack8(yv[q][i], f[i]);
#pragma unroll
                for (int j = 0; j < 8; ++j) { f[i][j] += xv[q][i][j >> 2][j & 3]; ss += f[i][j] * f[i][j]; } }
            ss = wave_sum_fast(ss); const float rs = rsqrtf(ss * (1.0f / D) + 1e-6f);
            float* orow = P.out + (size_t)(r2 * 2 + q) * D + lane * 8;
#pragma unroll
            for (int i = 0; i < 4; ++i) { f32x4 o0, o1;
#pragma unroll
                for (int j = 0; j < 4; ++j) { o0[j] = f[i][j] * rs * g[i][0][j]; o1[j] = f[i][4 + j] * rs * g[i][1][j]; }
                __builtin_nontemporal_store(o0, (f32x4*)(orow + i * 512)); __builtin_nontemporal_store(o1, (f32x4*)(orow + i * 512 + 4)); }
        }
    }
}

__device__ __attribute__((noinline)) void grid_sync_fn() { cg::this_grid().sync(); }
__device__ __attribute__((noinline)) void xbar_fn(unsigned* bar, LAS unsigned* st) { XcdBarrier b; b.bar = bar; b.x = xb_xcc_id(); b.st = (volatile LAS unsigned*)st; xcd_barrier(b); }
typedef const Params __attribute__((address_space(4)))* KP;
DI KP launder_kp() { KP p = (KP)__builtin_amdgcn_kernarg_segment_ptr(); asm volatile("" : "+s"(p)); return p; }
DI Params load_params() { KP k = launder_kp(); Params P;
    P.x = k->x; P.norm_g = k->norm_g; P.w_in = k->w_in; P.shift_mu = k->shift_mu; P.w0 = k->w0; P.w_up = k->w_up; P.a0 = k->a0; P.a_up = k->a_up;
    P.k_k = k->k_k; P.k_a = k->k_a; P.r_k = k->r_k; P.gn_w = k->gn_w; P.gn_b = k->gn_b; P.q_norm_g = k->q_norm_g; P.k_norm_g = k->k_norm_g;
    P.w_br = k->w_br; P.w_ba = k->w_ba; P.w_out = k->w_out; P.fng = k->fng; P.out = k->out; P.ws = k->ws; P.ph_lo = 0; P.ph_hi = 0; return P; }
__global__ void __launch_bounds__(512, 2) hybrid_fwd(Params PK) {
    extern __shared__ __attribute__((aligned(16))) unsigned char smem[];
    LAS unsigned char* lds = (LAS unsigned char*)smem;
    const int G = gridDim.x, cidx = blockIdx.x;
    { const int t_ = ltid(); if (t_ == 0) { *(LAS u32x4*)(lds + LDS_XB) = (u32x4){0u, 0u, 0u, 0u}; }
      if (blockIdx.x == 0) { KP kq_ = launder_kp(); unsigned* bw = (unsigned*)(kq_->ws + WS_XBAR); for (int i = t_; i < XCD_BAR_WORDS; i += 512) bw[i] = 0u; }
      __syncthreads(); }
#ifndef GEMM1_WGM
#define GEMM1_WGM 4
#endif
#ifndef PROBE_MASK
#define PROBE_MASK 0
#endif
#define PHASE(n) for (int rep_ = 0; rep_ < (((PROBE_MASK >> (n)) & 1) + 1); ++rep_)
#define SEAM(n) do { KP kq_ = launder_kp(); if ((n) == 0) { grid_sync_fn(); if (ltid() == 0) (void)xb_add(&((unsigned*)(kq_->ws + WS_XBAR))[XB_XCNT(xb_xcc_id())], 1u); }     else xbar_fn((unsigned*)(kq_->ws + WS_XBAR), (LAS unsigned*)(lds + LDS_XB)); } while (0)
#define LOADP() const Params P = load_params(); unsigned char* ws = P.ws; (void)ws
    PHASE(0) { LOADP(); p0_prologue(P, lds); }
    SEAM(0);
    PHASE(1) { LOADP(); pg8::Gemm g{(const bf16_t*)(ws + WS_H), (const bf16_t*)(ws + WS_WINT), NT, 4864, 2048}; pg8::StaticOrder S; S.init(NT, 4864, G, cidx); S.wgm = GEMM1_WGM;
        EpiSplit E{(bf16_t*)(ws + WS_PS), (bf16_t*)(ws + WS_PQKV)}; pg8::gemm_phase<EpiSplit, pg8::StaticOrder, true, true>(lds, g, S, E); }
    SEAM(1);
    PHASE(2) { LOADP(); p2_prep(P, lds); }
    SEAM(2);
    PHASE(3) { LOADP(); pg8::Gemm g{(const bf16_t*)(ws + WS_LORA), (const bf16_t*)(ws + WS_WLT), NT, 4096, 256}; pg8::StaticOrder S; S.init(NT, 4096, G, cidx);
        EpiLora E{(bf16_t*)P.out, (bf16_t*)(ws + WS_AA), P.w0, P.a0}; pg8::gemm_phase<EpiLora, pg8::StaticOrder, true, true>(lds, g, S, E); }
    SEAM(3);
    PHASE(4) { LOADP(); p3a_scan(P, lds, (((PROBE_MASK >> 4) & 1) && rep_ == 0) ? (float*)(ws + 720 * MiB) : P.out); }
    SEAM(4);
    PHASE(5) { LOADP(); p3b_attn(P, lds); }
    __syncthreads();
    PHASE(6) { LOADP(); pg8::Gemm g{(const bf16_t*)(ws + WS_H), (const bf16_t*)(ws + WS_WINT) + (size_t)4864 * 2048, NT, 6144, 2048}; pg8::StaticOrder S; S.init(NT, 6144, G, cidx); S.wgm = GEMM1_WGM;
        EpiPlain E{(bf16_t*)(ws + WS_PZG), ZGW}; pg8::gemm_phase<EpiPlain, pg8::StaticOrder, true, true>(lds, g, S, E); }
    SEAM(6);
    PHASE(7) { LOADP(); p4_post(P); }
    SEAM(7);
    PHASE(8) { LOADP(); pg8::Gemm g{(const bf16_t*)(ws + WS_TEMP), (const bf16_t*)(ws + WS_WRT), NT, 2048, 2048}; pg8::StaticOrder S; S.init(NT, 2048, G, cidx);
        EpiMerged E{(const bf16_t*)(ws + WS_PZG), (bf16_t*)(ws + WS_MERGED)}; pg8::gemm_phase<EpiMerged, pg8::StaticOrder, true, true>(lds, g, S, E); }
    SEAM(9);
    PHASE(10) { LOADP(); pg8::Gemm g{(const bf16_t*)(ws + WS_MERGED), (const bf16_t*)(ws + WS_WOT), NT, 2048, 2048}; pg8::StaticOrder S; S.init(NT, 2048, G, cidx);
        EpiOut E{(bf16_t*)(ws + WS_TEMP)}; pg8::gemm_phase<EpiOut, pg8::StaticOrder, true, true>(lds, g, S, E); }
    SEAM(10);
    PHASE(11) { LOADP(); p7_final(P); }
}

extern "C" void kernel_launch(void* const* d_in, const int* in_sizes, int n_in, void* d_out, int out_size, void* d_ws, size_t ws_size, hipStream_t stream) {
    static int grid = 0;
    if (grid == 0) {
        int dev = 0, cus = 0, per_cu = 0;
        hipGetDevice(&dev);
        hipDeviceGetAttribute(&cus, hipDeviceAttributeMultiprocessorCount, dev);
        if (hipFuncSetAttribute((const void*)hybrid_fwd, hipFuncAttributeMaxDynamicSharedMemorySize, LDS_BYTES) != hipSuccess) fprintf(stderr, "hipFuncSetAttribute failed\n");
        if (hipOccupancyMaxActiveBlocksPerMultiprocessor(&per_cu, (const void*)hybrid_fwd, 512, LDS_BYTES) != hipSuccess || per_cu < 1) { fprintf(stderr, "occupancy query: %d\n", per_cu); per_cu = 1; }
        (void)hipGetLastError();
        grid = cus * per_cu;
        if (ws_size < 1024 * MiB) fprintf(stderr, "workspace too small: %zu\n", ws_size);
    }
    Params p{};
    p.x = (const float*)d_in[0]; p.norm_g = (const float*)d_in[1]; p.w_in = (const float*)d_in[2]; p.shift_mu = (const float*)d_in[3]; p.w0 = (const float*)d_in[4];
    p.w_up = (const float*)d_in[5]; p.a0 = (const float*)d_in[6]; p.a_up = (const float*)d_in[7]; p.k_k = (const float*)d_in[8]; p.k_a = (const float*)d_in[9];
    p.r_k = (const float*)d_in[10]; p.gn_w = (const float*)d_in[11]; p.gn_b = (const float*)d_in[12]; p.q_norm_g = (const float*)d_in[13]; p.k_norm_g = (const float*)d_in[14];
    p.w_br = (const float*)d_in[15]; p.w_ba = (const float*)d_in[16]; p.w_out = (const float*)d_in[17]; p.fng = (const float*)d_in[18];
    p.out = (float*)d_out; p.ws = (unsigned char*)d_ws; p.ph_lo = 0; p.ph_hi = 12;
    void* args[] = {&p};
    hipError_t e = hipLaunchCooperativeKernel((const void*)hybrid_fwd, dim3(grid), dim3(512), args, LDS_BYTES, stream);
    if (e != hipSuccess) fprintf(stderr, "cooperative launch failed: %s (grid %d)\n", hipGetErrorString(e), grid);
}
```

```cpp
#include <hip/hip_runtime.h>
#include <hip/hip_cooperative_groups.h>
#include <cstdio>
#include <cstdint>
namespace cg = cooperative_groups;
#define PROBE_MASK 0
namespace pg8 {
#define PG8_LAS __attribute__((address_space(3)))
typedef unsigned short bf16_t;
typedef short bf16x8 __attribute__((ext_vector_type(8)));
typedef float f32x4 __attribute__((ext_vector_type(4)));
typedef unsigned u32x4 __attribute__((ext_vector_type(4)));
constexpr int BM = 256, BK = 64, HALF = 128, HTB = HALF * BK * 2  , STAGE_BYTES = 8 * HTB, NXCD = 8, WGM = 8;

__host__ __device__ __forceinline__ int lds_byte(int r, int c) { const int st = (r >> 4) * 2 + (c >> 5), rr = r & 15, cc = c & 31, ob = rr * 64 + cc * 2; return st * 1024 + (ob ^ (((ob >> 9) & 1) << 5)); }
__host__ __device__ __forceinline__ void stage_rc(int b, int& R, int& C) { const int st = b / 1024, sb = b % 1024, swz = sb ^ (((sb >> 9) & 1) << 5); R = (st >> 1) * 16 + swz / 64; C = (st & 1) * 32 + (swz % 64) / 2; }
__host__ __device__ __forceinline__ int perm32(int rho) { const int n = rho >> 4, i = rho & 15; return 8 * (i >> 2) + 4 * n + (i & 3); }

struct Unit { int pm, pn; };
struct Gemm { const bf16_t* A; const bf16_t* Bt; int M, N, K; };

struct StaticOrder {
    int nM, nN, nwg, G, c, wgm = 8;
    __host__ __device__ void init(int M, int N, int G_, int c_) { nM = M / BM; nN = N / BM; nwg = nM * nN; G = G_; c = c_; }
    __host__ __device__ bool next(int i, Unit& u) const {
        const long L = (long)i * G + c; if (L >= nwg) return false;
        int wgid = (int)L; { const int q = nwg / NXCD, r = nwg % NXCD, xcd = wgid % NXCD, off = wgid / NXCD; wgid = (xcd < r ? xcd * (q + 1) : r * (q + 1) + (xcd - r) * q) + off; }
        const int nig = wgm * nN, gid = wgid / nig, fm = gid * wgm, gsz = (nM - fm) < wgm ? (nM - fm) : wgm;
        u.pm = fm + ((wgid % nig) % gsz); u.pn = (wgid % nig) / gsz; return true;
    }
    __device__ __forceinline__ void a_ready(const Unit&) const {}
    __device__ __forceinline__ void done(const Unit&) const {}
};
__device__ __forceinline__ unsigned cvt_pk_bf16(float lo, float hi) { unsigned r; asm volatile("v_cvt_pk_bf16_f32 %0, %1, %2" : "=v"(r) : "v"(lo), "v"(hi)); return r; }
template <class Epi, class Sched, bool ALIGN_EPI = false, bool SP2 = false>
__device__ __forceinline__ void gemm_phase(PG8_LAS unsigned char* lds, const Gemm g, const Sched& S, const Epi& E) {
    int tid_l = threadIdx.x; asm volatile("" : "+v"(tid_l)); const int tid = tid_l, wid = __builtin_amdgcn_readfirstlane(tid >> 6), lane = tid & 63, wr = wid >> 2, wc = wid & 3, fr = lane & 15, fq = lane >> 4;
    const int K = g.K, nt = K / BK;
    unsigned voffA[2], voffB[2];
#pragma unroll
    for (int i = 0; i < 2; ++i) { int R, C; stage_rc(tid * 16 + i * 8192, R, C); const int Rb = Epi::PERM ? ((R & ~31) + perm32(R & 31)) : R;
        voffA[i] = (unsigned)(R * K + C) * 2u; voffB[i] = (unsigned)(Rb * K + C) * 2u; }
    const size_t kstep = (size_t)(BK * 2);
    const size_t hstep = (size_t)HALF * K * 2;
    const size_t tstep = 2 * hstep;
    const unsigned ldsw = (unsigned)wid * 1024u;
    const int aoff = lds_byte(wr * 64 + fr, fq * 8), boff = lds_byte(wc * 32 + fr, fq * 8);
#define PG8_SA(b, h) (((b) * 2 + (h)) * HTB)
#define PG8_SB(b, h) ((4 + (b) * 2 + (h)) * HTB)
#define PG8_STAGE(bufoff, gbase, voff) do { _Pragma("unroll") for (int _i = 0; _i < 2; ++_i) \
        __builtin_amdgcn_global_load_lds((const unsigned*)((const char*)(gbase) + (voff)[_i]), (PG8_LAS unsigned*)(lds + (bufoff) + ldsw + _i * 8192), 16, 0, 0); } while (0)
#define PG8_LDA(dst, b, h) do { _Pragma("unroll") for (int m = 0; m < 4; ++m) _Pragma("unroll") for (int k = 0; k < 2; ++k) dst[m][k] = *(const PG8_LAS bf16x8*)(lds + PG8_SA(b, h) + aoff + m * 2048 + k * 1024); } while (0)
#define PG8_LDB(dst, b, h) do { _Pragma("unroll") for (int n = 0; n < 2; ++n) _Pragma("unroll") for (int k = 0; k < 2; ++k) dst[n][k] = *(const PG8_LAS bf16x8*)(lds + PG8_SB(b, h) + boff + n * 2048 + k * 1024); } while (0)
#define PG8_MMA(ai, bj, At, Bt) do { __builtin_amdgcn_s_setprio(1); _Pragma("unroll") for (int m = 0; m < 4; ++m) _Pragma("unroll") for (int n = 0; n < 2; ++n) _Pragma("unroll") for (int k = 0; k < 2; ++k) \
        acc[ai][bj][m][n] = __builtin_amdgcn_mfma_f32_16x16x32_bf16(Bt[n][k], At[m][k], acc[ai][bj][m][n], 0, 0, 0); __builtin_amdgcn_s_setprio(0); } while (0)
#define PG8_WAIT_V(n) asm volatile("s_waitcnt vmcnt(" #n ")" ::: "memory")
#define PG8_WAIT_L(n) asm volatile("s_waitcnt lgkmcnt(" #n ")" ::: "memory")
#define PG8_BAR __builtin_amdgcn_s_barrier()
#define PG8_SCHED __builtin_amdgcn_sched_barrier(0)
    Unit cur, nxt; int ui = 0;
    if (!S.next(0, cur)) return;
    f32x4 acc[2][2][4][2];
#pragma unroll
    for (int a = 0; a < 2; ++a)
#pragma unroll
        for (int b = 0; b < 2; ++b)
#pragma unroll
            for (int m = 0; m < 4; ++m)
#pragma unroll
                for (int n = 0; n < 2; ++n) acc[a][b][m][n] = (f32x4){0.f, 0.f, 0.f, 0.f};
    bf16x8 At[4][2], B0[2][2], B1[2][2];
    const char* cA = (const char*)g.A + (size_t)cur.pm * tstep; const char* cB = (const char*)g.Bt + (size_t)cur.pn * tstep;
    S.a_ready(cur);
    if constexpr (SP2) {
        PG8_STAGE(PG8_SB(0, 0), cB, voffB); PG8_STAGE(PG8_SB(0, 1), cB + hstep, voffB); PG8_STAGE(PG8_SA(0, 0), cA, voffA); PG8_STAGE(PG8_SA(0, 1), cA + hstep, voffA);
        if (wr == 1) PG8_BAR;
        PG8_WAIT_V(2); PG8_BAR;
        PG8_STAGE(PG8_SB(1, 0), cB + kstep, voffB); PG8_STAGE(PG8_SA(1, 0), cA + kstep, voffA); PG8_STAGE(PG8_SB(1, 1), cB + hstep + kstep, voffB);
        PG8_WAIT_V(6); PG8_BAR;
    } else {
        PG8_STAGE(PG8_SB(0, 0), cB, voffB); PG8_STAGE(PG8_SA(0, 0), cA, voffA); PG8_STAGE(PG8_SB(0, 1), cB + hstep, voffB); PG8_STAGE(PG8_SA(0, 1), cA + hstep, voffA);
        if (wr == 1) PG8_BAR;
        PG8_WAIT_V(4); PG8_BAR;
        PG8_STAGE(PG8_SB(1, 0), cB + kstep, voffB); PG8_STAGE(PG8_SA(1, 0), cA + kstep, voffA); PG8_STAGE(PG8_SB(1, 1), cB + hstep + kstep, voffB);
        PG8_WAIT_V(6); PG8_BAR;
    }
    for (;;) {
        const bool has_next = S.next(ui + 1, nxt);
        const char* nA = has_next ? (const char*)g.A + (size_t)nxt.pm * tstep : cA; const char* nB = has_next ? (const char*)g.Bt + (size_t)nxt.pn * tstep : cB;
        constexpr int nseg = Epi::MID ? 2 : 1; const int seglen = nt / nseg;
        for (int seg = 0; seg < nseg; ++seg) {
        if constexpr (Epi::MID) { if (seg == 1) E.mid(acc, cur, wr, wc, fr, fq); }
        for (int t = seg * seglen; t < (seg + 1) * seglen; t += 2) {
            const bool last = (t == nt - 2);
            const char* a1 = cA + (size_t)(t + 1) * kstep;
            const char* a2 = last ? nA : cA + (size_t)(t + 2) * kstep; const char* b2 = last ? nB : cB + (size_t)(t + 2) * kstep;
            const char* a3 = a2 + kstep; const char* b3 = b2 + kstep;
            if (last && has_next) S.a_ready(nxt);
            if constexpr (SP2) {
            PG8_LDB(B0, 0, 0); PG8_LDB(B1, 0, 1); PG8_SCHED; PG8_LDA(At, 0, 0); PG8_STAGE(PG8_SA(1, 1), a1 + hstep, voffA);
            PG8_WAIT_V(8); PG8_WAIT_L(0); PG8_BAR; PG8_MMA(0, 0, At, B0); PG8_MMA(0, 1, At, B1); PG8_BAR; PG8_SCHED;
            PG8_LDA(At, 0, 1); PG8_STAGE(PG8_SB(0, 0), b2, voffB); PG8_STAGE(PG8_SB(0, 1), b2 + hstep, voffB); PG8_STAGE(PG8_SA(0, 0), a2, voffA);
            PG8_WAIT_V(8); PG8_WAIT_L(0); PG8_BAR; PG8_MMA(1, 0, At, B0); PG8_MMA(1, 1, At, B1); PG8_BAR; PG8_SCHED;
            PG8_LDB(B0, 1, 0); PG8_LDB(B1, 1, 1); PG8_SCHED; PG8_LDA(At, 1, 0); PG8_STAGE(PG8_SA(0, 1), a2 + hstep, voffA);
            PG8_WAIT_V(8); PG8_WAIT_L(0); PG8_BAR; PG8_MMA(0, 0, At, B0); PG8_MMA(0, 1, At, B1); PG8_BAR; PG8_SCHED;
            PG8_LDA(At, 1, 1); PG8_STAGE(PG8_SB(1, 0), b3, voffB); PG8_STAGE(PG8_SB(1, 1), b3 + hstep, voffB); PG8_STAGE(PG8_SA(1, 0), a3, voffA);
            PG8_WAIT_V(8); PG8_WAIT_L(0); PG8_BAR; PG8_MMA(1, 0, At, B0); PG8_MMA(1, 1, At, B1); PG8_BAR; PG8_SCHED;
            } else {
            PG8_LDB(B0, 0, 0); PG8_SCHED; PG8_LDA(At, 0, 0); PG8_STAGE(PG8_SA(1, 1), a1 + hstep, voffA);
            PG8_WAIT_L(8); PG8_BAR; PG8_WAIT_L(0); PG8_MMA(0, 0, At, B0); PG8_BAR; PG8_SCHED;
            PG8_LDB(B1, 0, 1); PG8_STAGE(PG8_SB(0, 0), b2, voffB);
            PG8_BAR; PG8_WAIT_L(0); PG8_MMA(0, 1, At, B1); PG8_BAR;
            PG8_LDA(At, 0, 1); PG8_STAGE(PG8_SA(0, 0), a2, voffA);
            PG8_BAR; PG8_WAIT_L(0); PG8_MMA(1, 0, At, B0); PG8_BAR; PG8_SCHED;
            PG8_STAGE(PG8_SB(0, 1), b2 + hstep, voffB);
            PG8_WAIT_V(6); PG8_BAR; PG8_MMA(1, 1, At, B1); PG8_BAR;
            PG8_LDB(B0, 1, 0); PG8_SCHED; PG8_LDA(At, 1, 0); PG8_STAGE(PG8_SA(0, 1), a2 + hstep, voffA);
            PG8_WAIT_L(8); PG8_BAR; PG8_WAIT_L(0); PG8_MMA(0, 0, At, B0); PG8_BAR; PG8_SCHED;
            PG8_LDB(B1, 1, 1); PG8_STAGE(PG8_SB(1, 0), b3, voffB);
            PG8_BAR; PG8_WAIT_L(0); PG8_MMA(0, 1, At, B1); PG8_BAR;
            PG8_LDA(At, 1, 1); PG8_STAGE(PG8_SA(1, 0), a3, voffA);
            PG8_BAR; PG8_WAIT_L(0); PG8_MMA(1, 0, At, B0); PG8_BAR; PG8_SCHED;
            PG8_STAGE(PG8_SB(1, 1), b3 + hstep, voffB);
            PG8_WAIT_V(6); PG8_BAR; PG8_MMA(1, 1, At, B1); PG8_BAR;
            }
        }
        }
        if constexpr (ALIGN_EPI) { if (wr == 0) PG8_BAR; }
        if constexpr (!Epi::AFTER_DRAIN) { E(acc, cur, wr, wc, fr, fq); S.done(cur); }
        if (!has_next) break;
#pragma unroll
        for (int a = 0; a < 2; ++a)
#pragma unroll
            for (int b = 0; b < 2; ++b)
#pragma unroll
                for (int m = 0; m < 4; ++m)
#pragma unroll
                    for (int n = 0; n < 2; ++n) acc[a][b][m][n] = (f32x4){0.f, 0.f, 0.f, 0.f};
        cur = nxt; cA = nA; cB = nB; ++ui;
        if constexpr (ALIGN_EPI) { if (wr == 1) PG8_BAR; }
    }
    PG8_WAIT_V(0);
    if constexpr (!ALIGN_EPI) { if (wr == 0) PG8_BAR; }
    PG8_BAR;
    if constexpr (Epi::AFTER_DRAIN) { E.fused(acc, cur, wr, wc, fr, fq, lds, wid, lane); S.done(cur); }
#undef PG8_SA
#undef PG8_SB
#undef PG8_STAGE
#undef PG8_LDA
#undef PG8_LDB
#undef PG8_MMA
#undef PG8_WAIT_V
#undef PG8_WAIT_L
#undef PG8_BAR
#undef PG8_SCHED
}
}

typedef unsigned short bf16_t;
typedef float f32x2 __attribute__((ext_vector_type(2)));
typedef float f32x4 __attribute__((ext_vector_type(4)));
typedef float f32x16 __attribute__((ext_vector_type(16)));
typedef short bf16x8 __attribute__((ext_vector_type(8)));
typedef short s16x4 __attribute__((ext_vector_type(4)));
typedef unsigned u32x4 __attribute__((ext_vector_type(4)));
typedef unsigned u32x2 __attribute__((ext_vector_type(2)));
typedef __bf16 bf16x2_t __attribute__((ext_vector_type(2)));
#define LAS __attribute__((address_space(3)))
#define DI __device__ __forceinline__
#define XB_TMO      128
#define XB_XCNT(j)  (256  + 64 * (j))
#define XB_XSUB(j)  (1280 + 64 * (j))
#define XB_XGEN(j)  (2304 + 64 * (j))
#define XB_TOP      3328
#define XB_TOPGEN   3392
#define XCD_BAR_WORDS 3456
#define XB_SPIN_CAP (1u << 18)

__device__ __forceinline__ unsigned xb_ld(unsigned* p)              { return __hip_atomic_load(p, __ATOMIC_RELAXED, __HIP_MEMORY_SCOPE_AGENT); }
__device__ __forceinline__ unsigned xb_add(unsigned* p, unsigned v) { return __hip_atomic_fetch_add(p, v, __ATOMIC_RELAXED, __HIP_MEMORY_SCOPE_AGENT); }
__device__ __forceinline__ unsigned xb_xcc_id() { return (unsigned)__builtin_amdgcn_s_getreg((3 << 11) | 20) & 0xFu; }
#define XB_SPIN(cond, bar) do { unsigned _sp = 0; while (cond) { __builtin_amdgcn_s_sleep(1); \
    if ((++_sp & 255u) == 0u) { if (xb_ld(&(bar)[XB_TMO])) break; if (_sp > XB_SPIN_CAP) { atomicAdd(&(bar)[XB_TMO], 1u); break; } } } } while (0)

struct XcdBarrier {
    unsigned* bar; unsigned x;
    volatile LAS unsigned* st;
};

__device__ __forceinline__ XcdBarrier xcd_barrier_post(unsigned* bar, volatile LAS unsigned* st) {
    XcdBarrier b; b.bar = bar; b.x = xb_xcc_id(); b.st = st;
    if (threadIdx.x == 0) (void)xb_add(&bar[XB_XCNT(b.x)], 1u);
    return b;
}
__device__ __forceinline__ void xcd_barrier_complete(unsigned* bar, unsigned x, unsigned& nloc, unsigned& nx) {
    const unsigned G = gridDim.x * gridDim.y * gridDim.z;
    unsigned sum, cnt, mine, sp = 0u;
    for (;;) {
        sum = 0u; cnt = 0u; mine = 0u;
#pragma unroll
        for (unsigned j = 0; j < 16; ++j) { const unsigned c = xb_ld(&bar[XB_XCNT(j)]); sum += c; cnt += (c > 0u) ? 1u : 0u; mine = (j == x) ? c : mine; }
        if (sum == G) break;
        __builtin_amdgcn_s_sleep(1);
        if ((++sp & 255u) == 0u) { if (xb_ld(&bar[XB_TMO])) break; if (sp > XB_SPIN_CAP) { atomicAdd(&bar[XB_TMO], 1u); break; } }
    }
    nloc = mine > 0u ? mine : 1u; nx = cnt > 0u ? cnt : 1u;
}

__device__ __forceinline__ void xcd_barrier(const XcdBarrier& b) {
    asm volatile("s_waitcnt vmcnt(0)" ::: "memory");
    __syncthreads();
    if (threadIdx.x == 0) {
        unsigned* bar = b.bar;
        __builtin_amdgcn_s_waitcnt(0);
        unsigned nloc = b.st[0], nx = b.st[1];
        if (nloc == 0u) { xcd_barrier_complete(bar, b.x, nloc, nx); b.st[0] = nloc; b.st[1] = nx; }
        const unsigned old = xb_add(&bar[XB_XSUB(b.x)], 1u);
        const unsigned gen = old / nloc;
        if (old + 1u == (gen + 1u) * nloc) {
            __builtin_amdgcn_fence(__ATOMIC_RELEASE, "agent");
            asm volatile("s_waitcnt vmcnt(0)" ::: "memory");
            const unsigned og = xb_add(&bar[XB_TOP], 1u);
            const unsigned tg = og / nx;
            if (og + 1u == (tg + 1u) * nx) xb_add(&bar[XB_TOPGEN], 1u);
            else XB_SPIN(xb_ld(&bar[XB_TOPGEN]) == tg, bar);
            __builtin_amdgcn_fence(__ATOMIC_ACQUIRE, "agent");
            xb_add(&bar[XB_XGEN(b.x)], 1u);
            asm volatile("s_waitcnt vmcnt(0)" ::: "memory");
        } else {
            XB_SPIN(xb_ld(&bar[XB_XGEN(b.x)]) == gen, bar);
            __builtin_amdgcn_fence(__ATOMIC_ACQUIRE, "agent");
            asm volatile("s_waitcnt vmcnt(0)" ::: "memory");
        }
    }
    __syncthreads();
}


constexpr int NT = 32768, T = 2048, D = 2048;
constexpr int SW = 3328, QKVW = 1536, ZGW = 6144;
constexpr size_t MiB = 1ull << 20;
constexpr size_t WS_WINT = 0, WS_WRT = 44 * MiB, WS_WAT = 48 * MiB, WS_WOT = 52 * MiB, WS_WLT = 60 * MiB,
    WS_H = 64 * MiB, WS_PS = 192 * MiB, WS_PQKV = 400 * MiB, WS_LORA = 496 * MiB, WS_AA = 512 * MiB, WS_VT = 640 * MiB,
    WS_OA = 496 * MiB, WS_COEF = 1008 * MiB, WS_PZG = 624 * MiB, WS_ORP = 400 * MiB, WS_TEMP = 64 * MiB, WS_MERGED = 320 * MiB;
constexpr size_t WS_RS = 720 * MiB, WS_KS = 784 * MiB, WS_VS = 848 * MiB, WS_KK = 912 * MiB;
constexpr int LDS_BYTES = 131072 + 256, LDS_XB = 131072;
constexpr size_t WS_XBAR = 1012 * MiB;
constexpr float QSCALE = 0.125f * 1.4426950408889634f;

struct Params {
    const float* x; const float* norm_g; const float* w_in; const float* shift_mu; const float* w0; const float* w_up; const float* a0; const float* a_up;
    const float* k_k; const float* k_a; const float* r_k; const float* gn_w; const float* gn_b; const float* q_norm_g; const float* k_norm_g;
    const float* w_br; const float* w_ba; const float* w_out; const float* fng;
    float* out; unsigned char* ws; int ph_lo, ph_hi;
};

DI int ltid() { int t = threadIdx.x; asm volatile("" : "+v"(t)); return t; }
DI float bf2f(unsigned v) { return __uint_as_float(v << 16); }
DI unsigned cvtpk(float lo, float hi) { f32x2 v = {lo, hi}; bf16x2_t b = __builtin_convertvector(v, bf16x2_t); return __builtin_bit_cast(unsigned, b); }
DI bf16_t f2bf(float f) { return (bf16_t)(cvtpk(f, 0.f) & 0xffffu); }
DI float wave_sum(float v) {
#pragma unroll
    for (int o = 32; o; o >>= 1) v += __shfl_xor(v, o);
    return v;
}
DI float sigm(float x) { return __builtin_amdgcn_rcpf(1.0f + __builtin_amdgcn_exp2f(-1.4426950408889634f * x)); }
DI float siluf(float x) { return x * sigm(x); }
template <int CTRL> DI float dppf(float x) { return __builtin_bit_cast(float, __builtin_amdgcn_update_dpp(0, __builtin_bit_cast(int, x), CTRL, 0xf, 0xf, true)); }
DI float wave_sum_fast(float x) {
    x += dppf<0xB1>(x); x += dppf<0x4E>(x); x += dppf<0x124>(x); x += dppf<0x128>(x);
    const int xi = __builtin_bit_cast(int, x);
    const float s0 = __builtin_bit_cast(float, __builtin_amdgcn_readlane(xi, 0)), s1 = __builtin_bit_cast(float, __builtin_amdgcn_readlane(xi, 16));
    const float s2 = __builtin_bit_cast(float, __builtin_amdgcn_readlane(xi, 32)), s3 = __builtin_bit_cast(float, __builtin_amdgcn_readlane(xi, 48));
    return (s0 + s1) + (s2 + s3);
}

DI float sum8(float x) { x += dppf<0xB1>(x); x += dppf<0x4E>(x); x += dppf<0x141>(x); return x; }
DI void unpack8(const u32x4 w, float (&f)[8]) {
#pragma unroll
    for (int i = 0; i < 4; ++i) { f[2 * i] = __uint_as_float(w[i] << 16); f[2 * i + 1] = __uint_as_float(w[i] & 0xffff0000u); }
}
DI u32x4 pack8(const float (&f)[8]) { u32x4 w; w.x = cvtpk(f[0], f[1]); w.y = cvtpk(f[2], f[3]); w.z = cvtpk(f[4], f[5]); w.w = cvtpk(f[6], f[7]); return w; }
using pg8::Unit;
struct EpiSplit {
    static constexpr bool PERM = true, AFTER_DRAIN = false, MID = false;
    bf16_t* ps; bf16_t* pq;
    DI void operator()(const f32x4 (&acc)[2][2][4][2], const Unit& u, int wr, int wc, int fr, int fq) const {
        int colt = u.pn * 256; bf16_t* base = ps; int ldc = SW;
        if (colt >= SW) { base = pq; ldc = QKVW; colt -= SW; }
        const int row0 = u.pm * 256 + wr * 64 + fr, col0 = colt + wc * 32 + 8 * fq;
#pragma unroll
        for (int ai = 0; ai < 2; ++ai)
#pragma unroll
            for (int m = 0; m < 4; ++m) { bf16_t* rowp = base + (size_t)(row0 + ai * 128 + m * 16) * ldc + col0;
#pragma unroll
                for (int bj = 0; bj < 2; ++bj) { const f32x4 v0 = acc[ai][bj][m][0], v1 = acc[ai][bj][m][1]; u32x4 w;
                    w.x = cvtpk(v0[0], v0[1]); w.y = cvtpk(v0[2], v0[3]); w.z = cvtpk(v1[0], v1[1]); w.w = cvtpk(v1[2], v1[3]);
                    *(u32x4*)(rowp + bj * 128) = w; } }
    }
};
struct EpiPlain {
    static constexpr bool PERM = true, AFTER_DRAIN = false, MID = false;
    bf16_t* o; int ldc;
    DI void operator()(const f32x4 (&acc)[2][2][4][2], const Unit& u, int wr, int wc, int fr, int fq) const {
        const int row0 = u.pm * 256 + wr * 64 + fr, col0 = u.pn * 256 + wc * 32 + 8 * fq;
#pragma unroll
        for (int ai = 0; ai < 2; ++ai)
#pragma unroll
            for (int m = 0; m < 4; ++m) { bf16_t* rowp = o + (size_t)(row0 + ai * 128 + m * 16) * ldc + col0;
#pragma unroll
                for (int bj = 0; bj < 2; ++bj) { const f32x4 v0 = acc[ai][bj][m][0], v1 = acc[ai][bj][m][1]; u32x4 w;
                    w.x = cvtpk(v0[0], v0[1]); w.y = cvtpk(v0[2], v0[3]); w.z = cvtpk(v1[0], v1[1]); w.w = cvtpk(v1[2], v1[3]);
                    *(u32x4*)(rowp + bj * 128) = w; } }
    }
};
struct EpiLora {
    static constexpr bool PERM = false, AFTER_DRAIN = false, MID = false;
    bf16_t* dec; bf16_t* aa; const float* w0; const float* a0;
    DI void operator()(const f32x4 (&acc)[2][2][4][2], const Unit& u, int wr, int wc, int fr, int fq) const {
        const int kind = u.pn >> 2, dir = kind & 1;
        const int row0 = u.pm * 256 + wr * 64 + fr, cc0 = (u.pn & 3) * 256 + wc * 32 + 4 * fq;
        const float* bias = (kind < 2 ? w0 : a0) + dir * 1024;
#pragma unroll
        for (int bj = 0; bj < 2; ++bj)
#pragma unroll
            for (int n = 0; n < 2; ++n) { const int cc = cc0 + bj * 128 + 16 * n; const f32x4 bv = *(const f32x4*)(bias + cc);
#pragma unroll
                for (int ai = 0; ai < 2; ++ai)
#pragma unroll
                    for (int m = 0; m < 4; ++m) { const size_t row = (size_t)dir * NT + row0 + ai * 128 + m * 16; const f32x4 v = acc[ai][bj][m][n] + bv;
                        if (kind < 2) { u32x2 w;
                            w.x = cvtpk(-0.8750256610856424f * sigm(v[0]), -0.8750256610856424f * sigm(v[1])); w.y = cvtpk(-0.8750256610856424f * sigm(v[2]), -0.8750256610856424f * sigm(v[3]));
                            *(u32x2*)(dec + row * 1024 + cc) = w;
                        } else { u32x2 w; w.x = cvtpk(sigm(v[0]), sigm(v[1])); w.y = cvtpk(sigm(v[2]), sigm(v[3])); *(u32x2*)(aa + row * 1024 + cc) = w; } } }
    }
};
struct EpiGateR {
    static constexpr bool PERM = true, AFTER_DRAIN = false, MID = false;
    bf16_t* temp; const bf16_t* pzg;
    DI void operator()(const f32x4 (&acc)[2][2][4][2], const Unit& u, int wr, int wc, int fr, int fq) const {
        const int row0 = u.pm * 256 + wr * 64 + fr, c0 = u.pn * 256 + wc * 32 + 8 * fq;
#pragma unroll
        for (int ai = 0; ai < 2; ++ai)
#pragma unroll
            for (int m = 0; m < 4; ++m) { const size_t row = row0 + ai * 128 + m * 16;
#pragma unroll
                for (int bj = 0; bj < 2; ++bj) { const int c = c0 + bj * 128; const u32x4 g = *(const u32x4*)(pzg + row * ZGW + 2048 + c);
                    const f32x4 v0 = acc[ai][bj][m][0], v1 = acc[ai][bj][m][1]; u32x4 w;
                    w.x = cvtpk(v0[0] * sigm(bf2f(g.x & 0xffffu)), v0[1] * sigm(bf2f(g.x >> 16)));
                    w.y = cvtpk(v0[2] * sigm(bf2f(g.y & 0xffffu)), v0[3] * sigm(bf2f(g.y >> 16)));
                    w.z = cvtpk(v1[0] * sigm(bf2f(g.z & 0xffffu)), v1[1] * sigm(bf2f(g.z >> 16)));
                    w.w = cvtpk(v1[2] * sigm(bf2f(g.w & 0xffffu)), v1[3] * sigm(bf2f(g.w >> 16)));
                    *(u32x4*)(temp + row * 2048 + c) = w; } }
    }
};
struct EpiGateA {
    static constexpr bool PERM = true, AFTER_DRAIN = false, MID = false;
    const bf16_t* temp; const bf16_t* pzg; bf16_t* merged;
    DI void operator()(const f32x4 (&acc)[2][2][4][2], const Unit& u, int wr, int wc, int fr, int fq) const {
        const int row0 = u.pm * 256 + wr * 64 + fr, c0 = u.pn * 256 + wc * 32 + 8 * fq;
#pragma unroll
        for (int ai = 0; ai < 2; ++ai)
#pragma unroll
            for (int m = 0; m < 4; ++m) { const size_t row = row0 + ai * 128 + m * 16;
#pragma unroll
                for (int bj = 0; bj < 2; ++bj) { const int c = c0 + bj * 128; const u32x4 g = *(const u32x4*)(pzg + row * ZGW + 4096 + c);
                    const u32x4 t = *(const u32x4*)(temp + row * 2048 + c); const f32x4 v0 = acc[ai][bj][m][0], v1 = acc[ai][bj][m][1]; u32x4 w;
                    w.x = cvtpk(bf2f(t.x & 0xffffu) + v0[0] * sigm(bf2f(g.x & 0xffffu)), bf2f(t.x >> 16) + v0[1] * sigm(bf2f(g.x >> 16)));
                    w.y = cvtpk(bf2f(t.y & 0xffffu) + v0[2] * sigm(bf2f(g.y & 0xffffu)), bf2f(t.y >> 16) + v0[3] * sigm(bf2f(g.y >> 16)));
                    w.z = cvtpk(bf2f(t.z & 0xffffu) + v1[0] * sigm(bf2f(g.z & 0xffffu)), bf2f(t.z >> 16) + v1[1] * sigm(bf2f(g.z >> 16)));
                    w.w = cvtpk(bf2f(t.w & 0xffffu) + v1[2] * sigm(bf2f(g.w & 0xffffu)), bf2f(t.w >> 16) + v1[3] * sigm(bf2f(g.w >> 16)));
                    *(u32x4*)(merged + row * 2048 + c) = w; } }
    }
};
struct EpiMerged {
    static constexpr bool PERM = true, AFTER_DRAIN = false, MID = true;
    const bf16_t* pzg; bf16_t* merged;
    DI void mid(f32x4 (&acc)[2][2][4][2], const Unit& u, int wr, int wc, int fr, int fq) const {
        int row0 = u.pm * 256 + wr * 64 + fr, c0 = u.pn * 256 + wc * 32 + 8 * fq;
        asm volatile("" : "+v"(row0), "+v"(c0));
#pragma unroll
        for (int ai = 0; ai < 2; ++ai)
#pragma unroll
            for (int m = 0; m < 4; ++m) { const size_t row = row0 + ai * 128 + m * 16;
#pragma unroll
                for (int bj = 0; bj < 2; ++bj) { const int c = c0 + bj * 128; const u32x4 gr = *(const u32x4*)(pzg + row * ZGW + 2048 + c), ga = *(const u32x4*)(pzg + row * ZGW + 4096 + c);
#pragma unroll
                    for (int i = 0; i < 4; ++i) {
                        const float r0 = sigm(bf2f(gr[i] & 0xffffu)) * (1.0f + __builtin_amdgcn_exp2f(-1.4426950408889634f * bf2f(ga[i] & 0xffffu)));
                        const float r1 = sigm(bf2f(gr[i] >> 16)) * (1.0f + __builtin_amdgcn_exp2f(-1.4426950408889634f * bf2f(ga[i] >> 16)));
                        acc[ai][bj][m][i >> 1][(i & 1) * 2] *= r0; acc[ai][bj][m][i >> 1][(i & 1) * 2 + 1] *= r1; } }
                if (m == 3) __builtin_amdgcn_sched_barrier(0); }
    }
    DI void operator()(const f32x4 (&acc)[2][2][4][2], const Unit& u, int wr, int wc, int fr, int fq) const {
        const int row0 = u.pm * 256 + wr * 64 + fr, c0 = u.pn * 256 + wc * 32 + 8 * fq;
#pragma unroll
        for (int ai = 0; ai < 2; ++ai)
#pragma unroll
            for (int m = 0; m < 4; ++m) { const size_t row = row0 + ai * 128 + m * 16;
#pragma unroll
                for (int bj = 0; bj < 2; ++bj) { const int c = c0 + bj * 128; const u32x4 g = *(const u32x4*)(pzg + row * ZGW + 4096 + c);
                    const f32x4 v0 = acc[ai][bj][m][0], v1 = acc[ai][bj][m][1]; u32x4 w;
                    w.x = cvtpk(v0[0] * sigm(bf2f(g.x & 0xffffu)), v0[1] * sigm(bf2f(g.x >> 16)));
                    w.y = cvtpk(v0[2] * sigm(bf2f(g.y & 0xffffu)), v0[3] * sigm(bf2f(g.y >> 16)));
                    w.z = cvtpk(v1[0] * sigm(bf2f(g.z & 0xffffu)), v1[1] * sigm(bf2f(g.z >> 16)));
                    w.w = cvtpk(v1[2] * sigm(bf2f(g.w & 0xffffu)), v1[3] * sigm(bf2f(g.w >> 16)));
                    *(u32x4*)(merged + row * 2048 + c) = w; } }
    }
};
struct EpiOut {
    static constexpr bool PERM = true, AFTER_DRAIN = false, MID = false;
    bf16_t* y;
    DI void operator()(const f32x4 (&acc)[2][2][4][2], const Unit& u, int wr, int wc, int fr, int fq) const {
        const int row0 = u.pm * 256 + wr * 64 + fr, c0 = u.pn * 256 + wc * 32 + 8 * fq;
#pragma unroll
        for (int ai = 0; ai < 2; ++ai)
#pragma unroll
            for (int m = 0; m < 4; ++m) { bf16_t* rowp = y + (size_t)(row0 + ai * 128 + m * 16) * 2048 + c0;
#pragma unroll
                for (int bj = 0; bj < 2; ++bj) { const f32x4 v0 = acc[ai][bj][m][0], v1 = acc[ai][bj][m][1]; u32x4 w;
                    w.x = cvtpk(v0[0], v0[1]); w.y = cvtpk(v0[2], v0[3]); w.z = cvtpk(v1[0], v1[1]); w.w = cvtpk(v1[2], v1[3]);
                    *(u32x4*)(rowp + bj * 128) = w; } }
    }
};

DI void transpose_tiles(const float* __restrict__ W, int K, int N, bf16_t* __restrict__ WT, int remap, LAS float* tile, int ldw) {
    const int tid = ltid(); const int ntn = N / 64, ntiles = ntn * (K / 64);
    for (int ti = blockIdx.x; ti < ntiles; ti += gridDim.x) {
        const int k0 = (ti / ntn) * 64, n0 = (ti % ntn) * 64;
#pragma unroll
        for (int i = 0; i < 2; ++i) { const int idx = tid + 512 * i, kk = idx >> 4, n4 = (idx & 15) * 4; const f32x4 v = *(const f32x4*)(W + (size_t)(k0 + kk) * N + n0 + n4);
            tile[kk * 65 + n4] = v[0]; tile[kk * 65 + n4 + 1] = v[1]; tile[kk * 65 + n4 + 2] = v[2]; tile[kk * 65 + n4 + 3] = v[3]; }
        __syncthreads();
        { const int nn = tid >> 3, kg = (tid & 7) * 8; int n = n0 + nn;
            if (remap) { if (n >= 3328 && n < 4352) n += 1536; else if (n >= 4352 && n < 5888) n -= 1024; }
            float f[8];
#pragma unroll
            for (int i = 0; i < 8; ++i) f[i] = tile[(kg + i) * 65 + nn];
            *(u32x4*)(WT + (size_t)n * ldw + k0 + kg) = pack8(f); }
        __syncthreads();
    }
}
DI void p0_prologue(const Params& P, LAS unsigned char* lds) {
    const int tid = ltid(), lane = tid & 63, wid = tid >> 6;
    const int gw = blockIdx.x * 8 + wid, nw = gridDim.x * 8;
    bf16_t* H = (bf16_t*)(P.ws + WS_H);
    for (int r2 = gw; r2 < NT / 2; r2 += nw) {
        f32x4 v[2][4][2];
#pragma unroll
        for (int q = 0; q < 2; ++q)
#pragma unroll
            for (int i = 0; i < 4; ++i) { const f32x4* xp = (const f32x4*)(P.x + (size_t)(r2 * 2 + q) * D + (i * 64 + lane) * 8); v[q][i][0] = __builtin_nontemporal_load(xp); v[q][i][1] = __builtin_nontemporal_load(xp + 1); }
#pragma unroll
        for (int q = 0; q < 2; ++q) {
            float ss = 0.f;
#pragma unroll
            for (int i = 0; i < 4; ++i)
#pragma unroll
                for (int h2 = 0; h2 < 2; ++h2) ss += v[q][i][h2][0] * v[q][i][h2][0] + v[q][i][h2][1] * v[q][i][h2][1] + v[q][i][h2][2] * v[q][i][h2][2] + v[q][i][h2][3] * v[q][i][h2][3];
            ss = wave_sum_fast(ss); const float rs = rsqrtf(ss * (1.0f / D) + 1e-6f);
#pragma unroll
            for (int i = 0; i < 4; ++i) { const f32x4* gp = (const f32x4*)(P.norm_g + (i * 64 + lane) * 8); const f32x4 g0 = gp[0], g1 = gp[1]; u32x4 w;
                w.x = cvtpk(v[q][i][0][0] * rs * g0[0], v[q][i][0][1] * rs * g0[1]); w.y = cvtpk(v[q][i][0][2] * rs * g0[2], v[q][i][0][3] * rs * g0[3]);
                w.z = cvtpk(v[q][i][1][0] * rs * g1[0], v[q][i][1][1] * rs * g1[1]); w.w = cvtpk(v[q][i][1][2] * rs * g1[2], v[q][i][1][3] * rs * g1[3]);
                *(u32x4*)(H + (size_t)(r2 * 2 + q) * D + (i * 64 + lane) * 8) = w; }
        }
    }
    LAS float* tile = (LAS float*)lds;
    transpose_tiles(P.w_in, 2048, 11008, (bf16_t*)(P.ws + WS_WINT), 1, tile, 2048);
    transpose_tiles(P.w_br, 1024, 2048, (bf16_t*)(P.ws + WS_WRT), 0, tile, 2048);
    transpose_tiles(P.w_ba, 1024, 2048, (bf16_t*)(P.ws + WS_WRT) + 1024, 0, tile, 2048);
    transpose_tiles(P.w_out, 2048, 2048, (bf16_t*)(P.ws + WS_WOT), 0, tile, 2048);
    bf16_t* WL = (bf16_t*)(P.ws + WS_WLT);
    for (int idx = blockIdx.x * 512 + tid; idx < 4096 * 256; idx += gridDim.x * 512) {
        const int n = idx >> 8, k = idx & 255, kind = n >> 10, cc = n & 1023, kb = k >> 6, r = k & 63; float val = 0.f;
        if (kb == kind) val = (kind < 2) ? P.w_up[(size_t)(kind * 64 + r) * 1024 + cc] : P.a_up[(size_t)((kind - 2) * 64 + r) * 1024 + cc];
        WL[idx] = f2bf(val);
    }
}

struct QkSlot { u32x4 x; f32x4 g0, g1; };
DI void qk_slot_load(const Params& P, int si, int lane, QkSlot& S) {
    const int tok = si / 3, part = si - tok * 3, l8 = lane & 7;
    const bf16_t* row = (const bf16_t*)(P.ws + WS_PQKV) + (size_t)tok * QKVW + part * 512 + lane * 8;
    S.x = (part < 2 || lane < 32) ? *(const u32x4*)row : (u32x4){0u, 0u, 0u, 0u};
    const float* g = (part < 2 ? P.q_norm_g : P.k_norm_g) + l8 * 8;
    S.g0 = *(const f32x4*)g; S.g1 = *(const f32x4*)(g + 4);
}
DI void qk_slot_process(const Params& P, int si, int lane, const QkSlot& S) {
    const int tok = si / 3, part = si - tok * 3, t = tok & (T - 1); int l8 = lane & 7; asm volatile("" : "+v"(l8));
    const float pos = (l8 < 4) ? (float)(t >> 6) : (float)(t & 63);
    const float gs = part < 2 ? QSCALE : 1.0f;
    float f[8]; unpack8(S.x, f); float ss = 0.f;
#pragma unroll
    for (int i = 0; i < 8; ++i) ss += f[i] * f[i];
    ss = sum8(ss); const float rs = rsqrtf(ss * (1.0f / 64.0f) + 1e-6f) * gs;
    float o[8];
#pragma unroll
    for (int i = 0; i < 4; ++i) {
        const float frq = exp2f(-(float)(2 * ((l8 * 4 + i) & 15)) * (13.287712379549449f / 32.0f)) * 0.15915494309189535f;
        float rev = pos * frq; rev -= floorf(rev); const float sn = __builtin_amdgcn_sinf(rev), cs = __builtin_amdgcn_cosf(rev);
        const float ga = i < 2 ? S.g0[2 * i] : S.g1[2 * i - 4], gb = i < 2 ? S.g0[2 * i + 1] : S.g1[2 * i - 3];
        const float a0 = f[2 * i] * rs * ga, a1 = f[2 * i + 1] * rs * gb;
        o[2 * i] = a0 * cs - a1 * sn; o[2 * i + 1] = a0 * sn + a1 * cs; }
    bf16_t* row = (bf16_t*)(P.ws + WS_PQKV) + (size_t)tok * QKVW + part * 512 + lane * 8;
    if (part < 2 || lane < 32) *(u32x4*)row = pack8(o);
}

DI void p2_prep(const Params& P, LAS unsigned char* lds) {
    const int tid = ltid(), lane = tid & 63, wid = tid >> 6;
    const int gw = blockIdx.x * 8 + wid, nw = gridDim.x * 8;
    const bf16_t* PS = (const bf16_t*)(P.ws + WS_PS);
    const u32x4 zero4 = {0u, 0u, 0u, 0u};
    {
        const int half = gw & 1, c0 = half * 512 + lane * 8;
        bf16_t* RS = (bf16_t*)(P.ws + WS_RS); bf16_t* KS = (bf16_t*)(P.ws + WS_KS); bf16_t* VS = (bf16_t*)(P.ws + WS_VS); bf16_t* KK = (bf16_t*)(P.ws + WS_KK);
        float m0[3][8], m1[3][8], kkc[8];
#pragma unroll
        for (int v = 0; v < 3; ++v)
#pragma unroll
            for (int i = 0; i < 8; ++i) { m0[v][i] = P.shift_mu[v * 1024 + c0 + i]; m1[v][i] = P.shift_mu[SW + v * 1024 + c0 + i]; }
#pragma unroll
        for (int i = 0; i < 8; ++i) kkc[i] = P.k_k[c0 + i];
        bf16_t* LORA = (bf16_t*)(P.ws + WS_LORA);
        const int cl = 3072 + half * 128 + lane * 2;
        const float ml0a = P.shift_mu[cl], ml0b = P.shift_mu[cl + 1], ml1a = P.shift_mu[SW + cl], ml1b = P.shift_mu[SW + cl + 1];
        for (int g4 = gw >> 1; g4 < NT / 4; g4 += nw >> 1) {
            const int tok0 = g4 * 4, t0 = tok0 & (T - 1);
            u32x4 rw[6][3]; unsigned lw[6];
#pragma unroll
            for (int r = 0; r < 6; ++r) { const int t = t0 - 1 + r; const bool ok = (t >= 0) && (t < T); const unsigned x = *(const unsigned*)(PS + (size_t)(ok ? tok0 - 1 + r : tok0) * SW + cl); lw[r] = ok ? x : 0u; }
#pragma unroll
            for (int r = 0; r < 6; ++r) { const int t = t0 - 1 + r; const bool ok = (t >= 0) && (t < T); const bf16_t* p = PS + (size_t)(ok ? tok0 - 1 + r : tok0) * SW + c0;
#pragma unroll
                for (int v = 0; v < 3; ++v) { const u32x4 x = *(const u32x4*)(p + v * 1024); rw[r][v] = ok ? x : zero4; } }
#pragma unroll
            for (int q = 0; q < 4; ++q) {
                float sh[3][8];
#pragma unroll
                for (int v = 0; v < 3; ++v) { float pv[8], y[8], nx[8]; unpack8(rw[q][v], pv); unpack8(rw[q + 1][v], y); unpack8(rw[q + 2][v], nx);
#pragma unroll
                    for (int i = 0; i < 8; ++i) sh[v][i] = y[i] + m0[v][i] * (pv[i] - y[i]) + m1[v][i] * (nx[i] - y[i]); }
                float kk[8]; float ss = 0.f;
#pragma unroll
                for (int i = 0; i < 8; ++i) { kk[i] = sh[1][i] * kkc[i]; ss += kk[i] * kk[i]; }
                ss = sum8(ss); const float rn = rsqrtf(fmaxf(ss, 1e-24f));
#pragma unroll
                for (int i = 0; i < 8; ++i) kk[i] *= rn;
                const size_t o = (size_t)(tok0 + q) * 1024 + c0;
                *(u32x4*)(RS + o) = pack8(sh[0]); *(u32x4*)(KS + o) = pack8(sh[1]); *(u32x4*)(VS + o) = pack8(sh[2]); *(u32x4*)(KK + o) = pack8(kk);
                { const float pa = bf2f(lw[q] & 0xffffu), pb_ = bf2f(lw[q] >> 16), ya = bf2f(lw[q + 1] & 0xffffu), yb = bf2f(lw[q + 1] >> 16), na_ = bf2f(lw[q + 2] & 0xffffu), nb = bf2f(lw[q + 2] >> 16);
                  float sa_ = ya + ml0a * (pa - ya) + ml1a * (na_ - ya), sb_ = yb + ml0b * (pb_ - yb) + ml1b * (nb - yb);
                  if (half == 0) { sa_ = 1.0f - 2.0f * __builtin_amdgcn_rcpf(1.0f + __builtin_amdgcn_exp2f(2.8853900817779268f * sa_)); sb_ = 1.0f - 2.0f * __builtin_amdgcn_rcpf(1.0f + __builtin_amdgcn_exp2f(2.8853900817779268f * sb_)); }
                  *(unsigned*)(LORA + (size_t)(tok0 + q) * 256 + half * 128 + lane * 2) = cvtpk(sa_, sb_); }
            }
        }
    }
    bf16_t* PQ = (bf16_t*)(P.ws + WS_PQKV);
}

struct G5 { f32x4 w, b, e, r, k; };
DI void p3a_scan(const Params& P, LAS unsigned char* lds, float* OB) {
    const int tid = ltid(), lane = tid & 63, wid = __builtin_amdgcn_readfirstlane(tid >> 6);
    constexpr int BS = 8, REC = 1536, K0OFF = BS * REC, BUF = BS * REC + 256, CH_LDS = 2 * BUF, NBATCH = T / BS;
    const bool scanner = wid < 4;
    if (scanner) __builtin_amdgcn_s_setprio(3);
    const int cw = (wid & 3) >> 1, part = wid & 1;
    LAS unsigned char* L = lds + cw * CH_LDS;
    const bf16_t* PS = (const bf16_t*)(P.ws + WS_PS);
    const bf16_t* AA = (const bf16_t*)(P.ws + WS_AA);
    const bf16_t* DEC = (const bf16_t*)P.out; float* COEF = (float*)(P.ws + WS_COEF);
    int qsi = blockIdx.x * 4 + (wid & 3); const int npw = gridDim.x * 4;
    for (int chain0 = blockIdx.x * 2; chain0 < 512; chain0 += gridDim.x * 2) {
        const int chain = chain0 + cw;
        const int dir = chain & 1, bh = chain >> 1, h = bh & 15, b = bh >> 4;
        const int tstep = dir ? -1 : 1, t0 = dir ? T - 1 : 0;
        const size_t tokbase = (size_t)b * T;
        if (!scanner) {
            QkSlot QS; int qcur = -1;
            const int c = h * 64 + lane;
            const float kac = P.k_a[c], rkc = P.r_k[c];
            const size_t cb = tokbase * 1024 + c;
            const bf16_t* rsb = (const bf16_t*)(P.ws + WS_RS) + cb; const bf16_t* ksb = (const bf16_t*)(P.ws + WS_KS) + cb;
            const bf16_t* vsb = (const bf16_t*)(P.ws + WS_VS) + cb; const bf16_t* kkb = (const bf16_t*)(P.ws + WS_KK) + cb;
            const bf16_t* aab = AA + (size_t)dir * NT * 1024 + cb;
            const bf16_t* decb = DEC + (size_t)dir * NT * 1024 + cb;
            float* coefb = COEF + ((size_t)dir * NT + tokbase) * 16 + h;
            const int woff = (lane >> 2) * 80 + (lane & 3) * 4;
            unsigned short l_r[4], l_k[4], l_v[4], l_kk[4], na[4], nwv[4];
#define PREP_LOAD(bt_) do { _Pragma("unroll") for (int jj = 0; jj < 4; ++jj) { const int s = (bt_) * BS + part * 4 + jj; const int to = (t0 + tstep * s) * 1024; \
                l_r[jj] = rsb[to]; l_k[jj] = ksb[to]; l_v[jj] = vsb[to]; l_kk[jj] = kkb[to]; na[jj] = aab[to]; nwv[jj] = decb[to]; } } while (0)
#define PREP_DO(bt_) do { LAS unsigned char* Bf = L + ((bt_) & 1) * BUF; _Pragma("unroll") for (int jj = 0; jj < 4; ++jj) { const int j = part * 4 + jj; const int s = (bt_) * BS + j; const int t = t0 + tstep * s; \
                const float rs = bf2f(l_r[jj]), ks = bf2f(l_k[jj]), vs = bf2f(l_v[jj]), kk = bf2f(l_kk[jj]); \
                const float a = bf2f(na[jj]), w = __builtin_amdgcn_exp2f(bf2f(nwv[jj])); const float bb = kk * a, ke = ks * (1.0f + (a - 1.0f) * kac); \
                const float cf = wave_sum_fast(rs * ke * rkc); if (lane == 0) coefb[t * 16] = cf; \
                LAS unsigned char* R = Bf + j * REC; \
                *(LAS float*)(R + woff) = w; *(LAS float*)(R + woff + 16) = bb; *(LAS float*)(R + woff + 32) = ke; *(LAS float*)(R + woff + 48) = rs; *(LAS float*)(R + 1280 + lane * 4) = vs; \
                if (j == 0) *(LAS float*)(Bf + K0OFF + lane * 4) = -kk; else *(LAS float*)(R - REC + woff + 64) = -kk; } } while (0)
            PREP_LOAD(0); PREP_DO(0); PREP_LOAD(1);
            __syncthreads();
            for (int bt = 0; bt < NBATCH; ++bt) {
                if (bt + 1 < NBATCH) { PREP_DO(bt + 1); if (bt + 2 < NBATCH) PREP_LOAD(bt + 2); }
                if (bt & 1) { if (qcur >= 0) { qk_slot_process(P, qcur, lane, QS); qcur = -1; } }
                else if (qsi < 3 * NT) { qk_slot_load(P, qsi, lane, QS); qcur = qsi; qsi += npw; }
                __syncthreads();
            }
            if (qcur >= 0) qk_slot_process(P, qcur, lane, QS);
            if (chain0 + (int)gridDim.x * 2 >= 512) for (; qsi < 3 * NT; qsi += npw) { qk_slot_load(P, qsi, lane, QS); qk_slot_process(P, qsi, lane, QS); }
#undef PREP_LOAD
#undef PREP_DO
        } else {
            const int kq = lane & 3, rsl = lane >> 2;
            const int rowA = part * 32 + rsl, rowB = rowA + 16;
            bf16_t* ob = (bf16_t*)OB + (size_t)2 * NT * 1024 + ((size_t)dir * NT + tokbase) * 1024 + h * 64;
            const int roff = kq * 320;
            LAS unsigned char* OW = lds + 102400 + wid * 4096;
            f32x2 SA[8], SB[8];
#pragma unroll
            for (int i = 0; i < 8; ++i) { SA[i] = (f32x2){0.f, 0.f}; SB[i] = (f32x2){0.f, 0.f}; }
            __syncthreads();
            for (int bt = 0; bt < NBATCH; ++bt) {
                const LAS unsigned char* Bf = L + (bt & 1) * BUF;
                f32x2 snA = {0.f, 0.f}, snB = {0.f, 0.f};
#pragma unroll
                for (int i = 0; i < 4; ++i) { const f32x4 k4 = *(const LAS f32x4*)(Bf + K0OFF + kq * 64 + i * 16);
                    snA += SA[2 * i] * k4.xy; snA += SA[2 * i + 1] * k4.zw; snB += SB[2 * i] * k4.xy; snB += SB[2 * i + 1] * k4.zw; }
                G5 buf[2][4];
#define SCAN_LDS(B_, j_) do { _Pragma("unroll") for (int i = 0; i < 4; ++i) { const LAS unsigned char* p_ = Bf + (j_) * REC + roff + i * 80; (B_)[i].w = *(const LAS f32x4*)(p_); (B_)[i].b = *(const LAS f32x4*)(p_ + 16); \
                    (B_)[i].e = *(const LAS f32x4*)(p_ + 32); (B_)[i].r = *(const LAS f32x4*)(p_ + 48); (B_)[i].k = *(const LAS f32x4*)(p_ + 64); } } while (0)
#define SCAN_LDS_H(B_, j_, i0_) do { _Pragma("unroll") for (int i = (i0_); i < (i0_) + 2; ++i) { const LAS unsigned char* p_ = Bf + (j_) * REC + roff + i * 80; (B_)[i].w = *(const LAS f32x4*)(p_); (B_)[i].b = *(const LAS f32x4*)(p_ + 16); \
                    (B_)[i].e = *(const LAS f32x4*)(p_ + 32); (B_)[i].r = *(const LAS f32x4*)(p_ + 48); (B_)[i].k = *(const LAS f32x4*)(p_ + 64); } } while (0)
                SCAN_LDS(buf[0], 0);
                float vA = *(const LAS float*)(Bf + 1280 + rowA * 4), vB = *(const LAS float*)(Bf + 1280 + rowB * 4);
#pragma unroll
                for (int j = 0; j < BS; ++j) {
                    float saA = snA.x + snA.y, saB = snB.x + snB.y;
                    saA += dppf<0xB1>(saA); saB += dppf<0xB1>(saB); saA += dppf<0x4E>(saA); saB += dppf<0x4E>(saB);
                    const f32x2 sa2A = {saA, saA}, sa2B = {saB, saB}, v2A = {vA, vA}, v2B = {vB, vB};
                    if (j + 1 < BS) { SCAN_LDS_H(buf[(j + 1) & 1], j + 1, 0); vA = *(const LAS float*)(Bf + (j + 1) * REC + 1280 + rowA * 4); vB = *(const LAS float*)(Bf + (j + 1) * REC + 1280 + rowB * 4); }
                    __builtin_amdgcn_sched_barrier(0);
                    f32x2 oA = {0.f, 0.f}, oB = {0.f, 0.f}; snA = (f32x2){0.f, 0.f}; snB = (f32x2){0.f, 0.f};
#pragma unroll
                    for (int i = 0; i < 4; ++i) {
                        if (i == 2) { __builtin_amdgcn_sched_barrier(0); if (j + 1 < BS) SCAN_LDS_H(buf[(j + 1) & 1], j + 1, 2); __builtin_amdgcn_sched_barrier(0); }
                        const G5& B = buf[j & 1][i];
                        f32x2 ta = v2A * B.e.xy; ta = sa2A * B.b.xy + ta; SA[2 * i] = SA[2 * i] * B.w.xy + ta; oA += SA[2 * i] * B.r.xy;
                        f32x2 tb = v2B * B.e.xy; tb = sa2B * B.b.xy + tb; SB[2 * i] = SB[2 * i] * B.w.xy + tb; oB += SB[2 * i] * B.r.xy;
                        f32x2 tc = v2A * B.e.zw; tc = sa2A * B.b.zw + tc; SA[2 * i + 1] = SA[2 * i + 1] * B.w.zw + tc; oA += SA[2 * i + 1] * B.r.zw;
                        f32x2 td = v2B * B.e.zw; td = sa2B * B.b.zw + td; SB[2 * i + 1] = SB[2 * i + 1] * B.w.zw + td; oB += SB[2 * i + 1] * B.r.zw;
                        if (j + 1 < BS) { snA += SA[2 * i] * B.k.xy; snB += SB[2 * i] * B.k.xy; snA += SA[2 * i + 1] * B.k.zw; snB += SB[2 * i + 1] * B.k.zw; }
                    }
                    __builtin_amdgcn_sched_barrier(0);
                    *(LAS float*)(OW + j * 512 + rsl * 16 + kq * 4) = oA.x + oA.y; *(LAS float*)(OW + j * 512 + (16 + rsl) * 16 + kq * 4) = oB.x + oB.y;
                }
                __builtin_amdgcn_fence(__ATOMIC_RELEASE, "wavefront"); __builtin_amdgcn_wave_barrier(); __builtin_amdgcn_fence(__ATOMIC_ACQUIRE, "wavefront");
                { const int js = lane >> 3, rg = (lane & 7) * 4;
                  float o4[4];
#pragma unroll
                  for (int i = 0; i < 4; ++i) { const f32x4 p4 = *(const LAS f32x4*)(OW + js * 512 + (rg + i) * 16); o4[i] = (p4.x + p4.y) + (p4.z + p4.w); }
                  const int t = t0 + tstep * (bt * BS + js);
                  u32x2 w; w.x = cvtpk(o4[0], o4[1]); w.y = cvtpk(o4[2], o4[3]);
                  *(u32x2*)(ob + (size_t)t * 1024 + part * 32 + rg) = w; }
                __builtin_amdgcn_fence(__ATOMIC_RELEASE, "wavefront"); __builtin_amdgcn_wave_barrier(); __builtin_amdgcn_fence(__ATOMIC_ACQUIRE, "wavefront");
#undef SCAN_LDS
#undef SCAN_LDS_H
                __syncthreads();
            }
        }
    }
    __builtin_amdgcn_s_setprio(0);
}

typedef short v4i16_t __attribute__((ext_vector_type(4)));
DI s16x4 vtr16(const LAS unsigned char* p) { return __builtin_bit_cast(s16x4, __builtin_amdgcn_ds_read_tr16_b64_v4i16((LAS v4i16_t*)p)); }
DI void p3b_attn(const Params& P, LAS unsigned char* lds) {
    const int tid = ltid(), lane = tid & 63, wid = __builtin_amdgcn_readfirstlane(tid >> 6);
    const int r = lane & 31, hh = lane >> 5;
    constexpr int RS = 144, TB = 64 * RS;
    const bf16_t* PQ = (const bf16_t*)(P.ws + WS_PQKV);
    bf16_t* OA = (bf16_t*)(P.ws + WS_OA);
    const int srow = tid >> 3, sseg = tid & 7;
    float mgq = fabsf(P.q_norm_g[lane]), mgk = fabsf(P.k_norm_g[lane]);
#pragma unroll
    for (int o = 32; o; o >>= 1) { mgq = fmaxf(mgq, __shfl_xor(mgq, o)); mgk = fmaxf(mgk, __shfl_xor(mgk, o)); }
    const float negM = -(64.0f * QSCALE * 1.02f) * mgq * mgk;
    f32x16 negM16;
#pragma unroll
    for (int i = 0; i < 16; ++i) negM16[i] = negM;
    const int vcu = (gridDim.x % 8 == 0) ? (int)(blockIdx.x % 8) * (int)(gridDim.x / 8) + (int)(blockIdx.x / 8) : (int)blockIdx.x;
    for (int u = vcu; u < 1024; u += gridDim.x) {
        const int qblk = u & 3, g = (u >> 2) & 3, hkv = (u >> 4) & 3, b = u >> 6, hq = hkv * 4 + g;
        const size_t tokb = (size_t)b * T;
        const int q0 = qblk * 512 + wid * 64;
        bf16x8 qf[2][4];
#pragma unroll
        for (int sub = 0; sub < 2; ++sub) { const bf16_t* qp = PQ + (tokb + q0 + sub * 32 + r) * QKVW + hq * 64 + 8 * hh;
#pragma unroll
            for (int ds = 0; ds < 4; ++ds) qf[sub][ds] = *(const bf16x8*)(qp + ds * 16); }
        const bf16_t* kg = PQ + (tokb + srow) * QKVW + 1024 + hkv * 64 + sseg * 8;
        const bf16_t* vg = PQ + (tokb + srow) * QKVW + 1280 + hkv * 64 + sseg * 8;
        u32x4 kreg = *(const u32x4*)kg, vreg = *(const u32x4*)vg;
        *(LAS u32x4*)(lds + srow * RS + sseg * 16) = kreg; *(LAS u32x4*)(lds + 2 * TB + srow * RS + sseg * 16) = vreg;
        __syncthreads();
        f32x16 o[2][2];
#pragma unroll
        for (int sub = 0; sub < 2; ++sub)
#pragma unroll
            for (int dt = 0; dt < 2; ++dt)
#pragma unroll
                for (int i = 0; i < 16; ++i) o[sub][dt][i] = 0.f;
        float lsum[2] = {0.f, 0.f};
        for (int kt = 0; kt < 32; ++kt) {
            const int cb = kt & 1;
            if (kt + 1 < 32) { kreg = *(const u32x4*)(kg + (size_t)(kt + 1) * 64 * QKVW); vreg = *(const u32x4*)(vg + (size_t)(kt + 1) * 64 * QKVW); }
            const LAS unsigned char* Kc = lds + cb * TB; const LAS unsigned char* Vc = lds + 2 * TB + cb * TB;
            f32x16 x[2][2];
#pragma unroll
            for (int sub = 0; sub < 2; ++sub) {
#pragma unroll
                for (int ds = 0; ds < 4; ++ds) {
                    const bf16x8 ka = *(const LAS bf16x8*)(Kc + r * RS + ds * 32 + hh * 16);
                    const bf16x8 kb = *(const LAS bf16x8*)(Kc + (32 + r) * RS + ds * 32 + hh * 16);
                    x[sub][0] = __builtin_amdgcn_mfma_f32_32x32x16_bf16(ka, qf[sub][ds], ds == 0 ? negM16 : x[sub][0], 0, 0, 0);
                    x[sub][1] = __builtin_amdgcn_mfma_f32_32x32x16_bf16(kb, qf[sub][ds], ds == 0 ? negM16 : x[sub][1], 0, 0, 0);
                }
            }
            bf16x8 pb[2][2][2];
#pragma unroll
            for (int sub = 0; sub < 2; ++sub) {
                f32x2 ps2 = {0.f, 0.f};
#pragma unroll
                for (int ks = 0; ks < 2; ++ks) {
#pragma unroll
                    for (int i = 0; i < 16; i += 2) { x[sub][ks][i] = __builtin_amdgcn_exp2f(x[sub][ks][i]); x[sub][ks][i + 1] = __builtin_amdgcn_exp2f(x[sub][ks][i + 1]); ps2 += (f32x2){x[sub][ks][i], x[sub][ks][i + 1]}; }
#pragma unroll
                    for (int s = 0; s < 2; ++s) { u32x4 w;
                        w.x = cvtpk(x[sub][ks][8 * s], x[sub][ks][8 * s + 1]); w.y = cvtpk(x[sub][ks][8 * s + 2], x[sub][ks][8 * s + 3]);
                        w.z = cvtpk(x[sub][ks][8 * s + 4], x[sub][ks][8 * s + 5]); w.w = cvtpk(x[sub][ks][8 * s + 6], x[sub][ks][8 * s + 7]);
                        pb[sub][ks][s] = __builtin_bit_cast(bf16x8, w); }
                }
                lsum[sub] += ps2.x + ps2.y;
            }
#pragma unroll
            for (int ks = 0; ks < 2; ++ks)
#pragma unroll
                for (int s = 0; s < 2; ++s) {
                    const LAS unsigned char* vp_ = Vc + (ks * 32 + 16 * s + 4 * hh + ((lane & 15) >> 2)) * RS + ((lane >> 4) & 1) * 32 + (lane & 3) * 8;
                    const s16x4 lo0 = vtr16(vp_), hi0 = vtr16(vp_ + 8 * RS), lo1 = vtr16(vp_ + 64), hi1 = vtr16(vp_ + 8 * RS + 64);
                    const bf16x8 va0 = __builtin_shufflevector(lo0, hi0, 0, 1, 2, 3, 4, 5, 6, 7), va1 = __builtin_shufflevector(lo1, hi1, 0, 1, 2, 3, 4, 5, 6, 7);
#pragma unroll
                    for (int sub = 0; sub < 2; ++sub) {
                        o[sub][0] = __builtin_amdgcn_mfma_f32_32x32x16_bf16(va0, pb[sub][ks][s], o[sub][0], 0, 0, 0);
                        o[sub][1] = __builtin_amdgcn_mfma_f32_32x32x16_bf16(va1, pb[sub][ks][s], o[sub][1], 0, 0, 0);
                    }
                }
            if (kt + 1 < 32) { *(LAS u32x4*)(lds + (cb ^ 1) * TB + srow * RS + sseg * 16) = kreg; *(LAS u32x4*)(lds + 2 * TB + (cb ^ 1) * TB + srow * RS + sseg * 16) = vreg; }
            __syncthreads();
        }
#pragma unroll
        for (int sub = 0; sub < 2; ++sub) {
            float l = lsum[sub]; l += __shfl_xor(l, 32);
            const float inv = 1.0f / l;
            bf16_t* op = OA + (tokb + q0 + sub * 32 + r) * 1024 + hq * 64 + 4 * hh;
#pragma unroll
            for (int gq = 0; gq < 4; ++gq) {
                u32x2 w; w.x = cvtpk(o[sub][0][4 * gq] * inv, o[sub][0][4 * gq + 1] * inv); w.y = cvtpk(o[sub][0][4 * gq + 2] * inv, o[sub][0][4 * gq + 3] * inv); *(u32x2*)(op + 8 * gq) = w;
                u32x2 w2; w2.x = cvtpk(o[sub][1][4 * gq] * inv, o[sub][1][4 * gq + 1] * inv); w2.y = cvtpk(o[sub][1][4 * gq + 2] * inv, o[sub][1][4 * gq + 3] * inv); *(u32x2*)(op + 32 + 8 * gq) = w2;
            }
        }
    }
}

DI void p4_post(const Params& P) {
    const int tid = ltid(), lane = tid & 63, wid = tid >> 6;
    const int gw = blockIdx.x * 8 + wid, nw = gridDim.x * 8;
    const bf16_t* O = (const bf16_t*)P.out + (size_t)2 * NT * 1024; const float* COEF = (const float*)(P.ws + WS_COEF);
    const bf16_t* PS = (const bf16_t*)(P.ws + WS_PS); const bf16_t* PZG = (const bf16_t*)(P.ws + WS_PZG);
    const bf16_t* OA = (const bf16_t*)(P.ws + WS_OA); bf16_t* AC = (bf16_t*)(P.ws + WS_TEMP);
    const int half = gw & 1, c0 = half * 512 + lane * 8, head = c0 >> 6;
    const u32x4 zero4 = {0u, 0u, 0u, 0u};
    float gw_[8], gb_[8], m0[8], m1[8];
#pragma unroll
    for (int i = 0; i < 8; ++i) { gw_[i] = P.gn_w[c0 + i]; gb_[i] = P.gn_b[c0 + i]; m0[i] = P.shift_mu[2048 + c0 + i]; m1[i] = P.shift_mu[SW + 2048 + c0 + i]; }
    for (int g2 = gw >> 1; g2 < NT / 2; g2 += nw >> 1) {
        const int tok0 = g2 * 2, t0 = tok0 & (T - 1);
        u32x4 oa_[2], ob_[2]; u32x4 vr[4], zr[2], za[2], oa[2]; float cf[2];
#pragma unroll
        for (int r = 0; r < 4; ++r) { const int t = t0 - 1 + r; const bool ok = (t >= 0) && (t < T); const u32x4 x = *(const u32x4*)(PS + (size_t)(ok ? tok0 - 1 + r : tok0) * SW + 2048 + c0); vr[r] = ok ? x : zero4; }
#pragma unroll
        for (int q = 0; q < 2; ++q) { const size_t tok = tok0 + q;
            oa_[q] = *(const u32x4*)(O + tok * 1024 + c0); ob_[q] = *(const u32x4*)(O + (NT + tok) * 1024 + c0);
            zr[q] = *(const u32x4*)(PZG + tok * ZGW + c0); za[q] = *(const u32x4*)(PZG + tok * ZGW + 1024 + c0); oa[q] = *(const u32x4*)(OA + tok * 1024 + c0);
            cf[q] = COEF[tok * 16 + head] + COEF[(NT + tok) * 16 + head]; }
#pragma unroll
        for (int q = 0; q < 2; ++q) { const size_t tok = tok0 + q;
            float wkv[8], wk2[8]; float sm = 0.f; unpack8(oa_[q], wkv); unpack8(ob_[q], wk2);
#pragma unroll
            for (int i = 0; i < 8; ++i) { wkv[i] += wk2[i]; sm += wkv[i]; }
            const float mu = sum8(sm) * (1.0f / 64.0f); float sv = 0.f;
#pragma unroll
            for (int i = 0; i < 8; ++i) { wkv[i] -= mu; sv += wkv[i] * wkv[i]; }
            const float rstd = rsqrtf(sum8(sv) * (1.0f / 64.0f) + 64e-5f);
            float pv[8], y[8], nx[8], z1[8], z2[8], av[8], o1[8], o2[8];
            unpack8(vr[q], pv); unpack8(vr[q + 1], y); unpack8(vr[q + 2], nx); unpack8(zr[q], z1); unpack8(za[q], z2); unpack8(oa[q], av);
#pragma unroll
            for (int i = 0; i < 8; ++i) { const float vs = y[i] + m0[i] * (pv[i] - y[i]) + m1[i] * (nx[i] - y[i]);
                o1[i] = (wkv[i] * rstd * gw_[i] + gb_[i] + cf[q] * vs) * siluf(z1[i]); o2[i] = av[i] * siluf(z2[i]); }
            *(u32x4*)(AC + tok * 2048 + c0) = pack8(o1); *(u32x4*)(AC + tok * 2048 + 1024 + c0) = pack8(o2);
        }
    }
}

DI void p7_final(const Params& P) {
    const int tid = ltid(), lane = tid & 63, wid = tid >> 6;
    const int gw = blockIdx.x * 8 + wid, nw = gridDim.x * 8;
    const bf16_t* Y = (const bf16_t*)(P.ws + WS_TEMP);
    f32x4 g[4][2];
#pragma unroll
    for (int i = 0; i < 4; ++i) { g[i][0] = *(const f32x4*)(P.fng + i * 512 + lane * 8); g[i][1] = *(const f32x4*)(P.fng + i * 512 + lane * 8 + 4); }
    for (int r2 = gw; r2 < NT / 2; r2 += nw) {
        u32x4 yv[2][4]; f32x4 xv[2][4][2];
#pragma unroll
        for (int q = 0; q < 2; ++q)
#pragma unroll
            for (int i = 0; i < 4; ++i) { const size_t o_ = (size_t)(r2 * 2 + q) * D + i * 512 + lane * 8; yv[q][i] = *(const u32x4*)(Y + o_); xv[q][i][0] = __builtin_nontemporal_load((const f32x4*)(P.x + o_)); xv[q][i][1] = __builtin_nontemporal_load((const f32x4*)(P.x + o_ + 4)); }
#pragma unroll
        for (int q = 0; q < 2; ++q) {
            float f[4][8]; float ss = 0.f;
#pragma unroll
            for (int i = 0; i < 4; ++i) { unpack8(yv[q][i], f[i]);
#pragma unroll
                for (int j = 0; j < 8; ++j) { f[i][j] += xv[q][i][j >> 2][j & 3]; ss += f[i][j] * f[i][j]; } }
            ss = wave_sum_fast(ss); const float rs = rsqrtf(ss * (1.0f / D) + 1e-6f);
            float* orow = P.out + (size_t)(r2 * 2 + q) * D + lane * 8;
#pragma unroll
            for (int i = 0; i < 4; ++i) { f32x4 o0, o1;
#pragma unroll
                for (int j = 0; j < 4; ++j) { o0[j] = f[i][j] * rs * g[i][0][j]; o1[j] = f[i][4 + j] * rs * g[i][1][j]; }
                __builtin_nontemporal_store(o0, (f32x4*)(orow + i * 512)); __builtin_nontemporal_store(o1, (f32x4*)(orow + i * 512 + 4)); }
        }
    }
}

__device__ __attribute__((noinline)) void grid_sync_fn() { cg::this_grid().sync(); }
__device__ __attribute__((noinline)) void xbar_fn(unsigned* bar, LAS unsigned* st) { XcdBarrier b; b.bar = bar; b.x = xb_xcc_id(); b.st = (volatile LAS unsigned*)st; xcd_barrier(b); }
typedef const Params __attribute__((address_space(4)))* KP;
DI KP launder_kp() { KP p = (KP)__builtin_amdgcn_kernarg_segment_ptr(); asm volatile("" : "+s"(p)); return p; }
DI Params load_params() { KP k = launder_kp(); Params P;
    P.x = k->x; P.norm_g = k->norm_g; P.w_in = k->w_in; P.shift_mu = k->shift_mu; P.w0 = k->w0; P.w_up = k->w_up; P.a0 = k->a0; P.a_up = k->a_up;
    P.k_k = k->k_k; P.k_a = k->k_a; P.r_k = k->r_k; P.gn_w = k->gn_w; P.gn_b = k->gn_b; P.q_norm_g = k->q_norm_g; P.k_norm_g = k->k_norm_g;
    P.w_br = k->w_br; P.w_ba = k->w_ba; P.w_out = k->w_out; P.fng = k->fng; P.out = k->out; P.ws = k->ws; P.ph_lo = 0; P.ph_hi = 0; return P; }
__global__ void __launch_bounds__(512, 2) hybrid_fwd(Params PK) {
    extern __shared__ __attribute__((aligned(16))) unsigned char smem[];
    LAS unsigned char* lds = (LAS unsigned char*)smem;
    const int G = gridDim.x, cidx = blockIdx.x;
    { const int t_ = ltid(); if (t_ == 0) { *(LAS u32x4*)(lds + LDS_XB) = (u32x4){0u, 0u, 0u, 0u}; }
      if (blockIdx.x == 0) { KP kq_ = launder_kp(); unsigned* bw = (unsigned*)(kq_->ws + WS_XBAR); for (int i = t_; i < XCD_BAR_WORDS; i += 512) bw[i] = 0u; }
      __syncthreads(); }
#ifndef GEMM1_WGM
#define GEMM1_WGM 4
#endif
#ifndef PROBE_MASK
#define PROBE_MASK 0
#endif
#define PHASE(n) for (int rep_ = 0; rep_ < (((PROBE_MASK >> (n)) & 1) + 1); ++rep_)
#define SEAM(n) do { KP kq_ = launder_kp(); if ((n) == 0) { grid_sync_fn(); if (ltid() == 0) (void)xb_add(&((unsigned*)(kq_->ws + WS_XBAR))[XB_XCNT(xb_xcc_id())], 1u); }     else xbar_fn((unsigned*)(kq_->ws + WS_XBAR), (LAS unsigned*)(lds + LDS_XB)); } while (0)
#define LOADP() const Params P = load_params(); unsigned char* ws = P.ws; (void)ws
    PHASE(0) { LOADP(); p0_prologue(P, lds); }
    SEAM(0);
    PHASE(1) { LOADP(); pg8::Gemm g{(const bf16_t*)(ws + WS_H), (const bf16_t*)(ws + WS_WINT), NT, 4864, 2048}; pg8::StaticOrder S; S.init(NT, 4864, G, cidx); S.wgm = GEMM1_WGM;
        EpiSplit E{(bf16_t*)(ws + WS_PS), (bf16_t*)(ws + WS_PQKV)}; pg8::gemm_phase<EpiSplit, pg8::StaticOrder, true, true>(lds, g, S, E); }
    SEAM(1);
    PHASE(2) { LOADP(); p2_prep(P, lds); }
    SEAM(2);
    PHASE(3) { LOADP(); pg8::Gemm g{(const bf16_t*)(ws + WS_LORA), (const bf16_t*)(ws + WS_WLT), NT, 4096, 256}; pg8::StaticOrder S; S.init(NT, 4096, G, cidx);
        EpiLora E{(bf16_t*)P.out, (bf16_t*)(ws + WS_AA), P.w0, P.a0}; pg8::gemm_phase<EpiLora, pg8::StaticOrder, true, true>(lds, g, S, E); }
    SEAM(3);
    PHASE(4) { LOADP(); p3a_scan(P, lds, (((PROBE_MASK >> 4) & 1) && rep_ == 0) ? (float*)(ws + 720 * MiB) : P.out); }
    SEAM(4);
    PHASE(5) { LOADP(); p3b_attn(P, lds); }
    __syncthreads();
    PHASE(6) { LOADP(); pg8::Gemm g{(const bf16_t*)(ws + WS_H), (const bf16_t*)(ws + WS_WINT) + (size_t)4864 * 2048, NT, 6144, 2048}; pg8::StaticOrder S; S.init(NT, 6144, G, cidx); S.wgm = GEMM1_WGM;
        EpiPlain E{(bf16_t*)(ws + WS_PZG), ZGW}; pg8::gemm_phase<EpiPlain, pg8::StaticOrder, true, true>(lds, g, S, E); }
    SEAM(6);
    PHASE(7) { LOADP(); p4_post(P); }
    SEAM(7);
    PHASE(8) { LOADP(); pg8::Gemm g{(const bf16_t*)(ws + WS_TEMP), (const bf16_t*)(ws + WS_WRT), NT, 2048, 2048}; pg8::StaticOrder S; S.init(NT, 2048, G, cidx);
        EpiMerged E{(const bf16_t*)(ws + WS_PZG), (bf16_t*)(ws + WS_MERGED)}; pg8::gemm_phase<EpiMerged, pg8::StaticOrder, true, true>(lds, g, S, E); }
    SEAM(9);
    PHASE(10) { LOADP(); pg8::Gemm g{(const bf16_t*)(ws + WS_MERGED), (const bf16_t*)(ws + WS_WOT), NT, 2048, 2048}; pg8::StaticOrder S; S.init(NT, 2048, G, cidx);
        EpiOut E{(bf16_t*)(ws + WS_TEMP)}; pg8::gemm_phase<EpiOut, pg8::StaticOrder, true, true>(lds, g, S, E); }
    SEAM(10);
    PHASE(11) { LOADP(); p7_final(P); }
}

extern "C" void kernel_launch(void* const* d_in, const int* in_sizes, int n_in, void* d_out, int out_size, void* d_ws, size_t ws_size, hipStream_t stream) {
    static int grid = 0;
    if (grid == 0) {
        int dev = 0, cus = 0, per_cu = 0;
        hipGetDevice(&dev);
        hipDeviceGetAttribute(&cus, hipDeviceAttributeMultiprocessorCount, dev);
        if (hipFuncSetAttribute((const void*)hybrid_fwd, hipFuncAttributeMaxDynamicSharedMemorySize, LDS_BYTES) != hipSuccess) fprintf(stderr, "hipFuncSetAttribute failed\n");
        if (hipOccupancyMaxActiveBlocksPerMultiprocessor(&per_cu, (const void*)hybrid_fwd, 512, LDS_BYTES) != hipSuccess || per_cu < 1) { fprintf(stderr, "occupancy query: %d\n", per_cu); per_cu = 1; }
        (void)hipGetLastError();
        grid = cus * per_cu;
        if (ws_size < 1024 * MiB) fprintf(stderr, "workspace too small: %zu\n", ws_size);
    }
    Params p{};
    p.x = (const float*)d_in[0]; p.norm_g = (const float*)d_in[1]; p.w_in = (const float*)d_in[2]; p.shift_mu = (const float*)d_in[3]; p.w0 = (const float*)d_in[4];
    p.w_up = (const float*)d_in[5]; p.a0 = (const float*)d_in[6]; p.a_up = (const float*)d_in[7]; p.k_k = (const float*)d_in[8]; p.k_a = (const float*)d_in[9];
    p.r_k = (const float*)d_in[10]; p.gn_w = (const float*)d_in[11]; p.gn_b = (const float*)d_in[12]; p.q_norm_g = (const float*)d_in[13]; p.k_norm_g = (const float*)d_in[14];
    p.w_br = (const float*)d_in[15]; p.w_ba = (const float*)d_in[16]; p.w_out = (const float*)d_in[17]; p.fng = (const float*)d_in[18];
    p.out = (float*)d_out; p.ws = (unsigned char*)d_ws; p.ph_lo = 0; p.ph_hi = 12;
    void* args[] = {&p};
    hipError_t e = hipLaunchCooperativeKernel((const void*)hybrid_fwd, dim3(grid), dim3(512), args, LDS_BYTES, stream);
    if (e != hipSuccess) fprintf(stderr, "cooperative launch failed: %s (grid %d)\n", hipGetErrorString(e), grid);
}
```
